# Optimizing an MI355X kernel written in HIP

```python
import math
import jax, jax.numpy as jnp
from jax import lax
import numpy as np

D_MODEL = 1024
BATCH = 1
SEQ = 16384
DEPTH = 2

HEAD_DIM = 64
N_MIX_HEADS = 12
SWA_KV_HEADS = 3
SWA_WINDOW = 128
DIL_GROUPS = ((128, 1), (512, 4), (2048, 16))
DIL_HEADS = 4
MAX_DIL = 16
N_MEM = 256
MEM_HEADS = 4
BLOCK = 128
N_BUCKETS = 32
MAX_DISTANCE = 2048
D_FF = 3584
N_EXPERTS = 8
TOP_K = 2
EPS = 1e-5
NEG = -1e30

SWA_IN = N_MIX_HEADS * HEAD_DIM + 2 * SWA_KV_HEADS * HEAD_DIM + MEM_HEADS * HEAD_DIM
DIL_IN = len(DIL_GROUPS) * 3 * DIL_HEADS * HEAD_DIM + MEM_HEADS * HEAD_DIM
SWA_CAT = N_MIX_HEADS * HEAD_DIM + MEM_HEADS * HEAD_DIM
DIL_CAT = DIL_HEADS * HEAD_DIM + MEM_HEADS * HEAD_DIM

kernel_name = "hybrid_swa_sink_dilated_moe_trunk"


def rmsnorm(x, g):
    xf = x.astype(jnp.float32)
    y = xf * lax.rsqrt(jnp.mean(xf * xf, axis=-1, keepdims=True) + EPS)
    return (y * g.astype(jnp.float32)).astype(x.dtype)


def t5_bucket(dist):
    max_exact = N_BUCKETS // 2
    d = jnp.maximum(dist, 0)
    ratio = jnp.maximum(d, 1).astype(jnp.float32) / max_exact
    large = max_exact + (jnp.log(ratio) / math.log(MAX_DISTANCE / max_exact)
                         * (N_BUCKETS - max_exact)).astype(jnp.int32)
    return jnp.where(d < max_exact, d, jnp.minimum(large, N_BUCKETS - 1))


def rel_bias(table, dist_tok, heads):
    b = table[t5_bucket(dist_tok)][..., heads]
    return jnp.moveaxis(b, -1, 0).astype(jnp.float32)


def band_offsets():
    qi = jnp.arange(BLOCK)[:, None]
    kj = jnp.arange(2 * BLOCK)[None, :]
    return qi + BLOCK - kj


def banded_attention(q, k, v, bias, max_dist, sink):
    nb = q.shape[2]
    shift = lambda a: jnp.pad(a, ((0, 0), (0, 0), (1, 0)) + ((0, 0),) * (a.ndim - 3))[:, :, :-1]
    kk = jnp.concatenate([shift(k), k], axis=3)
    vv = jnp.concatenate([shift(v), v], axis=3)
    dist = band_offsets()
    kj = jnp.arange(2 * BLOCK)
    has_prev = (jnp.arange(nb) > 0)[:, None, None] | (kj >= BLOCK)[None, None, :]
    valid = (dist >= 0) & (dist <= max_dist) & has_prev
    s = jnp.einsum('brnqhgd,brnkhd->brnhgqk', q * (HEAD_DIM ** -0.5), kk).astype(jnp.float32) + bias
    s = jnp.where(valid[:, None, None], s, NEG)
    m = jnp.max(s, axis=-1)
    if sink is not None:
        m = jnp.maximum(m, sink[:, :, None])
    p = jnp.exp(s - m[..., None])
    denom = jnp.sum(p, axis=-1)
    if sink is not None:
        denom = denom + jnp.exp(sink[:, :, None] - m)
    p = p / denom[..., None]
    o = jnp.einsum('brnhgqk,brnkhd->brnqhgd', p.astype(vv.dtype), vv)
    return o, m + jnp.log(denom)


def to_dilated(a, d):
    B, sp = a.shape[:2]
    a = a.reshape(B, sp // d, d, *a.shape[2:])
    a = jnp.swapaxes(a, 1, 2)
    return a.reshape(B, d, sp // (d * BLOCK), BLOCK, *a.shape[3:])


def from_dilated(a):
    B, d, nb, L = a.shape[:4]
    a = a.reshape(B, d, nb * L, *a.shape[4:])
    a = jnp.swapaxes(a, 1, 2)
    return a.reshape(B, nb * L * d, *a.shape[3:])


def memory_attention(qm, mem_n, w_mem_kv):
    B, S, _ = qm.shape
    kv = jnp.einsum('bmd,de->bme', mem_n, w_mem_kv).reshape(B, mem_n.shape[1], 2, MEM_HEADS, HEAD_DIM)
    q = qm.reshape(B, S, MEM_HEADS, HEAD_DIM) * (HEAD_DIM ** -0.5)
    s = jnp.einsum('bshd,bmhd->bhsm', q, kv[:, :, 0]).astype(jnp.float32)
    p = jax.nn.softmax(s, axis=-1).astype(qm.dtype)
    return jnp.einsum('bhsm,bmhd->bshd', p, kv[:, :, 1]).reshape(B, S, MEM_HEADS * HEAD_DIM)


def swa_sink_mixer(h, mem_n, table, w_in, sinks, w_mem_kv, w_out):
    B, S, _ = h.shape
    nb = S // BLOCK
    g = N_MIX_HEADS // SWA_KV_HEADS
    dq, dkv = N_MIX_HEADS * HEAD_DIM, SWA_KV_HEADS * HEAD_DIM
    p = jnp.einsum('bsd,de->bse', h, w_in)
    q, k, v, qm = jnp.split(p, [dq, dq + dkv, dq + 2 * dkv], axis=-1)
    q = q.reshape(B, 1, nb, BLOCK, SWA_KV_HEADS, g, HEAD_DIM)
    k = k.reshape(B, 1, nb, BLOCK, SWA_KV_HEADS, HEAD_DIM)
    v = v.reshape(B, 1, nb, BLOCK, SWA_KV_HEADS, HEAD_DIM)
    bias = rel_bias(table, band_offsets(), slice(0, N_MIX_HEADS)).reshape(SWA_KV_HEADS, g, BLOCK, 2 * BLOCK)
    o, _ = banded_attention(q, k, v, bias, SWA_WINDOW - 1,
                            sinks.astype(jnp.float32).reshape(SWA_KV_HEADS, g))
    o = o.reshape(B, S, dq)
    om = memory_attention(qm, mem_n, w_mem_kv)
    return jnp.einsum('bse,ed->bsd', jnp.concatenate([o, om], axis=-1), w_out)


def dilated_mixer(h, mem_n, table, w_in, w_mem_kv, w_out):
    B, S, _ = h.shape
    n_grp = len(DIL_GROUPS)
    dg = 3 * DIL_HEADS * HEAD_DIM
    p = jnp.einsum('bsd,de->bse', h, w_in)
    pg, qm = p[..., :n_grp * dg], p[..., n_grp * dg:]
    unit = MAX_DIL * BLOCK
    sp = -(-S // unit) * unit
    pg = jnp.pad(pg, ((0, 0), (0, sp - S), (0, 0))).reshape(B, sp, n_grp, 3, DIL_HEADS, HEAD_DIM)
    outs, lses = [], []
    for gi, (window, dil) in enumerate(DIL_GROUPS):
        q, k, v = (to_dilated(pg[:, :, gi, c], dil) for c in range(3))
        bias = rel_bias(table, band_offsets() * dil, slice(gi * DIL_HEADS, (gi + 1) * DIL_HEADS))[:, None]
        o, lse = banded_attention(q[:, :, :, :, :, None], k, v, bias, window // dil, None)
        outs.append(from_dilated(o[..., 0, :]))
        lses.append(from_dilated(jnp.moveaxis(lse[..., 0, :], -1, 3)))
    w = jax.nn.softmax(jnp.stack(lses), axis=0)
    o = jnp.sum(w[..., None] * jnp.stack(outs).astype(jnp.float32), axis=0)[:, :S]
    o = o.astype(h.dtype).reshape(B, S, DIL_HEADS * HEAD_DIM)
    om = memory_attention(qm, mem_n, w_mem_kv)
    return jnp.einsum('bse,ed->bsd', jnp.concatenate([o, om], axis=-1), w_out)


def swiglu(h, w_gate, w_up, w_down):
    a = jnp.einsum('bsd,df->bsf', h, w_gate)
    b = jnp.einsum('bsd,df->bsf', h, w_up)
    return jnp.einsum('bsf,fd->bsd', jax.nn.silu(a) * b, w_down)


def moe_swiglu(h, router, w_gate, w_up, w_down):
    logits = jnp.einsum('bsd,de->bse', h, router).astype(jnp.float32)
    vals, idx = lax.top_k(logits, TOP_K)
    gates = jax.nn.softmax(vals, axis=-1)
    combine = jnp.sum(jax.nn.one_hot(idx, N_EXPERTS, dtype=jnp.float32) * gates[..., None], axis=-2)
    y = jnp.zeros_like(h)
    for e in range(N_EXPERTS):
        y = y + combine[..., e:e + 1].astype(h.dtype) * swiglu(h, w_gate[e], w_up[e], w_down[e])
    return y


def setup_inputs(seed: int = 0) -> dict:
    key = jax.random.key(seed)
    ks = iter(jax.random.split(key, 32))
    f32 = jnp.float32
    n_even, n_odd = (DEPTH + 1) // 2, DEPTH // 2

    def nrm(shape, scale):
        return jax.random.normal(next(ks), shape, f32) * scale

    def gain(shape):
        return 1.0 + nrm(shape, 0.02)

    d = D_MODEL
    return {
        "x": nrm((BATCH, SEQ, d), 1.0),
        "mem": nrm((BATCH, N_MEM, d), 1.0),
        "rel_bias_table": nrm((N_BUCKETS, N_MIX_HEADS), 0.2),
        "mem_norm": gain((d,)),
        "norm_mix": gain((DEPTH, d)),
        "norm_ffn": gain((DEPTH, d)),
        "final_norm": gain((d,)),
        "swa_w_in": nrm((n_even, d, SWA_IN), d ** -0.5),
        "swa_sinks": nrm((n_even, N_MIX_HEADS), 0.5),
        "swa_w_mem_kv": nrm((n_even, d, 2 * MEM_HEADS * HEAD_DIM), d ** -0.5),
        "swa_w_out": nrm((n_even, SWA_CAT, d), SWA_CAT ** -0.5),
        "dil_w_in": nrm((n_odd, d, DIL_IN), d ** -0.5),
        "dil_w_mem_kv": nrm((n_odd, d, 2 * MEM_HEADS * HEAD_DIM), d ** -0.5),
        "dil_w_out": nrm((n_odd, DIL_CAT, d), DIL_CAT ** -0.5),
        "ffn_gate": nrm((n_even, d, D_FF), d ** -0.5),
        "ffn_up": nrm((n_even, d, D_FF), d ** -0.5),
        "ffn_down": nrm((n_even, D_FF, d), D_FF ** -0.5),
        "router": nrm((n_odd, d, N_EXPERTS), d ** -0.5),
        "moe_gate": nrm((n_odd, N_EXPERTS, d, D_FF), d ** -0.5),
        "moe_up": nrm((n_odd, N_EXPERTS, d, D_FF), d ** -0.5),
        "moe_down": nrm((n_odd, N_EXPERTS, D_FF, d), D_FF ** -0.5),
    }


def reference(x, mem, rel_bias_table, mem_norm, norm_mix, norm_ffn, final_norm,
              swa_w_in, swa_sinks, swa_w_mem_kv, swa_w_out,
              dil_w_in, dil_w_mem_kv, dil_w_out,
              ffn_gate, ffn_up, ffn_down,
              router, moe_gate, moe_up, moe_down):
    h = x
    mem_n = rmsnorm(mem, mem_norm)
    for i in range(DEPTH):
        j = i // 2
        hn = rmsnorm(h, norm_mix[i])
        if i % 2 == 0:
            h = h + swa_sink_mixer(hn, mem_n, rel_bias_table, swa_w_in[j], swa_sinks[j],
                                   swa_w_mem_kv[j], swa_w_out[j])
            h = h + swiglu(rmsnorm(h, norm_ffn[i]), ffn_gate[j], ffn_up[j], ffn_down[j])
        else:
            h = h + dilated_mixer(hn, mem_n, rel_bias_table, dil_w_in[j], dil_w_mem_kv[j], dil_w_out[j])
            h = h + moe_swiglu(rmsnorm(h, norm_ffn[i]), router[j], moe_gate[j], moe_up[j], moe_down[j])
    return rmsnorm(h, final_norm)
```

```cpp
#include <hip/hip_runtime.h>
#include <cstdio>
#include <cstdint>
#include <cmath>
namespace pg8 {
#define PG8_LAS __attribute__((address_space(3)))
typedef unsigned short bf16_t;
typedef short bf16x8 __attribute__((ext_vector_type(8)));
typedef float f32x4 __attribute__((ext_vector_type(4)));
typedef unsigned u32x4 __attribute__((ext_vector_type(4)));
constexpr int BM = 256, BK = 64, HALF = 128, HTB = HALF * BK * 2  , STAGE_BYTES = 8 * HTB, NXCD = 8, WGM = 8;

__host__ __device__ __forceinline__ int lds_byte(int r, int c) { const int st = (r >> 4) * 2 + (c >> 5), rr = r & 15, cc = c & 31, ob = rr * 64 + cc * 2; return st * 1024 + (ob ^ (((ob >> 9) & 1) << 5)); }
__host__ __device__ __forceinline__ void stage_rc(int b, int& R, int& C) { const int st = b / 1024, sb = b % 1024, swz = sb ^ (((sb >> 9) & 1) << 5); R = (st >> 1) * 16 + swz / 64; C = (st & 1) * 32 + (swz % 64) / 2; }
__host__ __device__ __forceinline__ int perm32(int rho) { const int n = rho >> 4, i = rho & 15; return 8 * (i >> 2) + 4 * n + (i & 3); }

struct Unit { int pm, pn; };
struct Gemm { const bf16_t* A; const bf16_t* Bt; int M, N, K; };

struct StaticOrder {
    int nM, nN, nwg, G, c;
    __host__ __device__ void init(int M, int N, int G_, int c_) { nM = M / BM; nN = N / BM; nwg = nM * nN; G = G_; c = c_; }
    __host__ __device__ bool next(int i, Unit& u) const {
        const long L = (long)i * G + c; if (L >= nwg) return false;
        int wgid = (int)L; { const int q = nwg / NXCD, r = nwg % NXCD, xcd = wgid % NXCD, off = wgid / NXCD; wgid = (xcd < r ? xcd * (q + 1) : r * (q + 1) + (xcd - r) * q) + off; }
        const int nig = WGM * nN, gid = wgid / nig, fm = gid * WGM, gsz = (nM - fm) < WGM ? (nM - fm) : WGM;
        u.pm = fm + ((wgid % nig) % gsz); u.pn = (wgid % nig) / gsz; return true;
    }
    __device__ __forceinline__ void a_ready(const Unit&) const {}
    __device__ __forceinline__ void done(const Unit&) const {}
};

typedef float f32x2 __attribute__((ext_vector_type(2)));
typedef __bf16 bf16x2_t __attribute__((ext_vector_type(2)));
__device__ __forceinline__ unsigned cvt_pk_bf16(float lo, float hi) { const f32x2 v = {lo, hi}; const bf16x2_t b = __builtin_convertvector(v, bf16x2_t); return __builtin_bit_cast(unsigned, b); }

struct EpiPlainBf16 {
    static constexpr bool PERM = true, AFTER_DRAIN = false;
    bf16_t* O; int ldc;
    __device__ __forceinline__ void operator()(const f32x4 (&acc)[2][2][4][2], const Unit& u, int wr, int wc, int fr, int fq) const {
        const int row0 = u.pm * BM + wr * 64 + fr, col0 = u.pn * BM + wc * 32 + 8 * fq;
#pragma unroll
        for (int ai = 0; ai < 2; ++ai)
#pragma unroll
            for (int m = 0; m < 4; ++m) { bf16_t* rowp = O + (size_t)(row0 + ai * HALF + m * 16) * ldc + col0;
#pragma unroll
                for (int bj = 0; bj < 2; ++bj) { const f32x4 v0 = acc[ai][bj][m][0], v1 = acc[ai][bj][m][1];
                    u32x4 w; w.x = cvt_pk_bf16(v0[0], v0[1]); w.y = cvt_pk_bf16(v0[2], v0[3]); w.z = cvt_pk_bf16(v1[0], v1[1]); w.w = cvt_pk_bf16(v1[2], v1[3]);
                    *(u32x4*)(rowp + bj * HALF) = w; } }
    }
};
struct EpiResF32 {
    static constexpr bool PERM = false, AFTER_DRAIN = false;
    const float* base; float* out; int ldc;
    __device__ __forceinline__ void operator()(const f32x4 (&acc)[2][2][4][2], const Unit& u, int wr, int wc, int fr, int fq) const {
        const int col0 = u.pn * BM + wc * 32 + 4 * fq;
#pragma unroll
        for (int ai = 0; ai < 2; ++ai)
#pragma unroll
            for (int m = 0; m < 4; ++m) { const size_t off = (size_t)(u.pm * BM + ai * HALF + wr * 64 + m * 16 + fr) * ldc + col0;
#pragma unroll
                for (int bj = 0; bj < 2; ++bj)
#pragma unroll
                    for (int n = 0; n < 2; ++n) { const f32x4 b = *(const f32x4*)(base + off + bj * HALF + n * 16); *(f32x4*)(out + off + bj * HALF + n * 16) = b + acc[ai][bj][m][n]; } }
    }
};
__device__ __forceinline__ float silu_mul(float g, float u) { return g * __builtin_amdgcn_rcpf(1.0f + __builtin_amdgcn_exp2f(g * -1.4426950408889634f)) * u; }
struct EpiSwiglu {
    static constexpr bool PERM = true, AFTER_DRAIN = false;
    bf16_t* O; int ldc; int pn_mod;
    __device__ __forceinline__ void operator()(const f32x4 (&acc)[2][2][4][2], const Unit& u, int wr, int wc, int fr, int fq) const {
        const int row0 = u.pm * BM + wr * 64 + fr, col0 = (u.pn % pn_mod) * HALF + wc * 32 + 8 * fq;
#pragma unroll
        for (int ai = 0; ai < 2; ++ai)
#pragma unroll
            for (int m = 0; m < 4; ++m) { bf16_t* rowp = O + (size_t)(row0 + ai * HALF + m * 16) * ldc + col0;
                const f32x4 g0 = acc[ai][0][m][0], g1 = acc[ai][0][m][1], u0 = acc[ai][1][m][0], u1 = acc[ai][1][m][1];
                u32x4 w; w.x = cvt_pk_bf16(silu_mul(g0[0], u0[0]), silu_mul(g0[1], u0[1])); w.y = cvt_pk_bf16(silu_mul(g0[2], u0[2]), silu_mul(g0[3], u0[3]));
                w.z = cvt_pk_bf16(silu_mul(g1[0], u1[0]), silu_mul(g1[1], u1[1])); w.w = cvt_pk_bf16(silu_mul(g1[2], u1[2]), silu_mul(g1[3], u1[3]));
                *(u32x4*)rowp = w; }
    }
};
struct EpiMoeDown {
    static constexpr bool PERM = true, AFTER_DRAIN = false;
    bf16_t* O; const int* dest; const float* gate; int tile0;
    __device__ __forceinline__ void operator()(const f32x4 (&acc)[2][2][4][2], const Unit& u, int wr, int wc, int fr, int fq) const {
        const int slot0 = (tile0 + u.pm) * BM + wr * 64 + fr, col0 = (u.pn & 3) * BM + wc * 32 + 8 * fq;
#pragma unroll
        for (int ai = 0; ai < 2; ++ai)
#pragma unroll
            for (int m = 0; m < 4; ++m) { const int slot = slot0 + ai * HALF + m * 16; const int d = dest[slot];
                if (d >= 0) { const float gt = gate[slot]; bf16_t* rowp = O + (size_t)d * 1024 + col0;
#pragma unroll
                    for (int bj = 0; bj < 2; ++bj) { const f32x4 v0 = acc[ai][bj][m][0] * gt, v1 = acc[ai][bj][m][1] * gt;
                        u32x4 w; w.x = cvt_pk_bf16(v0[0], v0[1]); w.y = cvt_pk_bf16(v0[2], v0[3]); w.z = cvt_pk_bf16(v1[0], v1[1]); w.w = cvt_pk_bf16(v1[2], v1[3]);
                        *(u32x4*)(rowp + bj * HALF) = w; } } }
    }
};
template <int NN> struct MoeOrder {
    int nT, nwg, c, tile0; unsigned recip; const PG8_LAS int* tp;
    __device__ __forceinline__ void init(int nT_, int c_, int tile0_, const PG8_LAS int* tp_) { nT = nT_; nwg = nT_ * NN; c = c_; tile0 = tile0_; tp = tp_;
        recip = nT_ > 0 ? (unsigned)(__builtin_amdgcn_rcpf((float)nT_) * 1048576.0f) + 1u : 0u; }
    __device__ __forceinline__ bool next(int i, Unit& u) const {
        const int L = i * 256 + c; if (L >= nwg) return false;
        const int pn = (int)(((unsigned)L * recip) >> 20), pm = L - pn * nT;
        const int gt = tile0 + pm; int e = 0;
#pragma unroll
        for (int k = 1; k < 8; ++k) e += (gt >= tp[k]) ? 1 : 0;
        u.pm = pm; u.pn = e * NN + pn; return true;
    }
    __device__ __forceinline__ void a_ready(const Unit&) const {}
    __device__ __forceinline__ void done(const Unit&) const {}
};

template <class Epi, class Sched, bool ALIGN_EPI = false, bool SP2 = false>
__device__ __forceinline__ void gemm_phase(PG8_LAS unsigned char* lds, const Gemm g, const Sched& S, const Epi& E) {
    const int tid = threadIdx.x, wid = __builtin_amdgcn_readfirstlane(tid >> 6), lane = tid & 63, wr = wid >> 2, wc = wid & 3, fr = lane & 15, fq = lane >> 4;
    const int K = g.K, nt = K / BK;
    unsigned voffA[2], voffB[2];
#pragma unroll
    for (int i = 0; i < 2; ++i) { int R, C; stage_rc(tid * 16 + i * 8192, R, C); const int Rb = Epi::PERM ? ((R & ~31) + perm32(R & 31)) : R;
        voffA[i] = (unsigned)(R * K + C) * 2u; voffB[i] = (unsigned)(Rb * K + C) * 2u; }
    const size_t kstep = (size_t)(BK * 2);
    const size_t hstep = (size_t)HALF * K * 2;
    const size_t tstep = 2 * hstep;
    const unsigned ldsw = (unsigned)wid * 1024u;
    const int aoff = lds_byte(wr * 64 + fr, fq * 8), boff = lds_byte(wc * 32 + fr, fq * 8);
#define PG8_SA(b, h) (((b) * 2 + (h)) * HTB)
#define PG8_SB(b, h) ((4 + (b) * 2 + (h)) * HTB)
#define PG8_STAGE(bufoff, gbase, voff) do { _Pragma("unroll") for (int _i = 0; _i < 2; ++_i) \
        __builtin_amdgcn_global_load_lds((const unsigned*)((const char*)(gbase) + (voff)[_i]), (PG8_LAS unsigned*)(lds + (bufoff) + ldsw + _i * 8192), 16, 0, 0); } while (0)
#define PG8_LDA(dst, b, h) do { _Pragma("unroll") for (int m = 0; m < 4; ++m) _Pragma("unroll") for (int k = 0; k < 2; ++k) dst[m][k] = *(const PG8_LAS bf16x8*)(lds + PG8_SA(b, h) + aoff + m * 2048 + k * 1024); } while (0)
#define PG8_LDB(dst, b, h) do { _Pragma("unroll") for (int n = 0; n < 2; ++n) _Pragma("unroll") for (int k = 0; k < 2; ++k) dst[n][k] = *(const PG8_LAS bf16x8*)(lds + PG8_SB(b, h) + boff + n * 2048 + k * 1024); } while (0)
#define PG8_MMA(ai, bj, At, Bt) do { __builtin_amdgcn_s_setprio(1); _Pragma("unroll") for (int m = 0; m < 4; ++m) _Pragma("unroll") for (int n = 0; n < 2; ++n) _Pragma("unroll") for (int k = 0; k < 2; ++k) \
        acc[ai][bj][m][n] = __builtin_amdgcn_mfma_f32_16x16x32_bf16(Bt[n][k], At[m][k], acc[ai][bj][m][n], 0, 0, 0); __builtin_amdgcn_s_setprio(0); } while (0)
#define PG8_WAIT_V(n) asm volatile("s_waitcnt vmcnt(" #n ")" ::: "memory")
#define PG8_WAIT_L(n) asm volatile("s_waitcnt lgkmcnt(" #n ")" ::: "memory")
#define PG8_BAR __builtin_amdgcn_s_barrier()
#define PG8_SCHED __builtin_amdgcn_sched_barrier(0)
    Unit cur, nxt; int ui = 0;
    if (!S.next(0, cur)) return;
    f32x4 acc[2][2][4][2];
#pragma unroll
    for (int a = 0; a < 2; ++a)
#pragma unroll
        for (int b = 0; b < 2; ++b)
#pragma unroll
            for (int m = 0; m < 4; ++m)
#pragma unroll
                for (int n = 0; n < 2; ++n) acc[a][b][m][n] = (f32x4){0.f, 0.f, 0.f, 0.f};
    bf16x8 At[4][2], B0[2][2], B1[2][2];
    const char* cA = (const char*)g.A + (size_t)cur.pm * tstep; const char* cB = (const char*)g.Bt + (size_t)cur.pn * tstep;
    S.a_ready(cur);
    if constexpr (SP2) {
        PG8_STAGE(PG8_SB(0, 0), cB, voffB); PG8_STAGE(PG8_SB(0, 1), cB + hstep, voffB); PG8_STAGE(PG8_SA(0, 0), cA, voffA); PG8_STAGE(PG8_SA(0, 1), cA + hstep, voffA);
        if (wr == 1) PG8_BAR;
        PG8_WAIT_V(2); PG8_BAR;
        PG8_STAGE(PG8_SB(1, 0), cB + kstep, voffB); PG8_STAGE(PG8_SA(1, 0), cA + kstep, voffA); PG8_STAGE(PG8_SB(1, 1), cB + hstep + kstep, voffB);
        PG8_WAIT_V(6); PG8_BAR;
    } else {
        PG8_STAGE(PG8_SB(0, 0), cB, voffB); PG8_STAGE(PG8_SA(0, 0), cA, voffA); PG8_STAGE(PG8_SB(0, 1), cB + hstep, voffB); PG8_STAGE(PG8_SA(0, 1), cA + hstep, voffA);
        if (wr == 1) PG8_BAR;
        PG8_WAIT_V(4); PG8_BAR;
        PG8_STAGE(PG8_SB(1, 0), cB + kstep, voffB); PG8_STAGE(PG8_SA(1, 0), cA + kstep, voffA); PG8_STAGE(PG8_SB(1, 1), cB + hstep + kstep, voffB);
        PG8_WAIT_V(6); PG8_BAR;
    }
    for (;;) {
        const bool has_next = S.next(ui + 1, nxt);
        const char* nA = has_next ? (const char*)g.A + (size_t)nxt.pm * tstep : cA; const char* nB = has_next ? (const char*)g.Bt + (size_t)nxt.pn * tstep : cB;
        for (int t = 0; t < nt; t += 2) {
            const bool last = (t == nt - 2);
            const char* a1 = cA + (size_t)(t + 1) * kstep;
            const char* a2 = last ? nA : cA + (size_t)(t + 2) * kstep; const char* b2 = last ? nB : cB + (size_t)(t + 2) * kstep;
            const char* a3 = a2 + kstep; const char* b3 = b2 + kstep;
            if (last && has_next) S.a_ready(nxt);
            if constexpr (SP2) {
            PG8_LDB(B0, 0, 0); PG8_LDB(B1, 0, 1); PG8_SCHED; PG8_LDA(At, 0, 0); PG8_STAGE(PG8_SA(1, 1), a1 + hstep, voffA);
            PG8_WAIT_V(8); PG8_WAIT_L(0); PG8_BAR; PG8_MMA(0, 0, At, B0); PG8_MMA(0, 1, At, B1); PG8_BAR; PG8_SCHED;
            PG8_LDA(At, 0, 1); PG8_STAGE(PG8_SB(0, 0), b2, voffB); PG8_STAGE(PG8_SB(0, 1), b2 + hstep, voffB); PG8_STAGE(PG8_SA(0, 0), a2, voffA);
            PG8_WAIT_V(8); PG8_WAIT_L(0); PG8_BAR; PG8_MMA(1, 0, At, B0); PG8_MMA(1, 1, At, B1); PG8_BAR; PG8_SCHED;
            PG8_LDB(B0, 1, 0); PG8_LDB(B1, 1, 1); PG8_SCHED; PG8_LDA(At, 1, 0); PG8_STAGE(PG8_SA(0, 1), a2 + hstep, voffA);
            PG8_WAIT_V(8); PG8_WAIT_L(0); PG8_BAR; PG8_MMA(0, 0, At, B0); PG8_MMA(0, 1, At, B1); PG8_BAR; PG8_SCHED;
            PG8_LDA(At, 1, 1); PG8_STAGE(PG8_SB(1, 0), b3, voffB); PG8_STAGE(PG8_SB(1, 1), b3 + hstep, voffB); PG8_STAGE(PG8_SA(1, 0), a3, voffA);
            PG8_WAIT_V(8); PG8_WAIT_L(0); PG8_BAR; PG8_MMA(1, 0, At, B0); PG8_MMA(1, 1, At, B1); PG8_BAR; PG8_SCHED;
            } else {
            PG8_LDB(B0, 0, 0); PG8_SCHED; PG8_LDA(At, 0, 0); PG8_STAGE(PG8_SA(1, 1), a1 + hstep, voffA);
            PG8_WAIT_L(8); PG8_BAR; PG8_WAIT_L(0); PG8_MMA(0, 0, At, B0); PG8_BAR; PG8_SCHED;
            PG8_LDB(B1, 0, 1); PG8_STAGE(PG8_SB(0, 0), b2, voffB);
            PG8_BAR; PG8_WAIT_L(0); PG8_MMA(0, 1, At, B1); PG8_BAR;
            PG8_LDA(At, 0, 1); PG8_STAGE(PG8_SA(0, 0), a2, voffA);
            PG8_BAR; PG8_WAIT_L(0); PG8_MMA(1, 0, At, B0); PG8_BAR; PG8_SCHED;
            PG8_STAGE(PG8_SB(0, 1), b2 + hstep, voffB);
            PG8_WAIT_V(6); PG8_BAR; PG8_MMA(1, 1, At, B1); PG8_BAR;
            PG8_LDB(B0, 1, 0); PG8_SCHED; PG8_LDA(At, 1, 0); PG8_STAGE(PG8_SA(0, 1), a2 + hstep, voffA);
            PG8_WAIT_L(8); PG8_BAR; PG8_WAIT_L(0); PG8_MMA(0, 0, At, B0); PG8_BAR; PG8_SCHED;
            PG8_LDB(B1, 1, 1); PG8_STAGE(PG8_SB(1, 0), b3, voffB);
            PG8_BAR; PG8_WAIT_L(0); PG8_MMA(0, 1, At, B1); PG8_BAR;
            PG8_LDA(At, 1, 1); PG8_STAGE(PG8_SA(1, 0), a3, voffA);
            PG8_BAR; PG8_WAIT_L(0); PG8_MMA(1, 0, At, B0); PG8_BAR; PG8_SCHED;
            PG8_STAGE(PG8_SB(1, 1), b3 + hstep, voffB);
            PG8_WAIT_V(6); PG8_BAR; PG8_MMA(1, 1, At, B1); PG8_BAR;
            }
        }
        if constexpr (ALIGN_EPI) { if (wr == 0) PG8_BAR; }
        if constexpr (!Epi::AFTER_DRAIN) { E(acc, cur, wr, wc, fr, fq); S.done(cur); }
        if (!has_next) break;
#pragma unroll
        for (int a = 0; a < 2; ++a)
#pragma unroll
            for (int b = 0; b < 2; ++b)
#pragma unroll
                for (int m = 0; m < 4; ++m)
#pragma unroll
                    for (int n = 0; n < 2; ++n) acc[a][b][m][n] = (f32x4){0.f, 0.f, 0.f, 0.f};
        cur = nxt; cA = nA; cB = nB; ++ui;
        if constexpr (ALIGN_EPI) { if (wr == 1) PG8_BAR; }
    }
    PG8_WAIT_V(0);
    if constexpr (!ALIGN_EPI) { if (wr == 0) PG8_BAR; }
    PG8_BAR;
    if constexpr (Epi::AFTER_DRAIN) { E.fused(acc, cur, wr, wc, fr, fq, lds, wid, lane); S.done(cur); }
#undef PG8_SA
#undef PG8_SB
#undef PG8_STAGE
#undef PG8_LDA
#undef PG8_LDB
#undef PG8_MMA
#undef PG8_WAIT_V
#undef PG8_WAIT_L
#undef PG8_BAR
#undef PG8_SCHED
}
}

#define GAS __attribute__((address_space(1)))
#define LAS __attribute__((address_space(3)))
typedef unsigned short bf16;
typedef unsigned v4u __attribute__((ext_vector_type(4)));
typedef float f32x4 __attribute__((ext_vector_type(4)));
typedef short bf16x8 __attribute__((ext_vector_type(8)));
typedef GAS unsigned gu32;
typedef GAS unsigned long long gu64;
#define RLX_AGENT __ATOMIC_RELAXED, __HIP_MEMORY_SCOPE_AGENT
#define LDS_WAIT() asm volatile("s_waitcnt lgkmcnt(0)" ::: "memory")
#define VM_WAIT() asm volatile("s_waitcnt vmcnt(0)" ::: "memory")
__device__ __forceinline__ unsigned long long rt() { return __builtin_amdgcn_s_memrealtime(); }
__device__ __forceinline__ unsigned f2bf(float f) { unsigned u = __builtin_bit_cast(unsigned, f); return (u + 0x7fffu + ((u >> 16) & 1u)) >> 16; }
__device__ __forceinline__ unsigned pk2(float lo, float hi) { return f2bf(lo) | (f2bf(hi) << 16); }

#define XB_TMO      128
#define XB_XCNT(j)  (256  + 64 * (j))
#define XB_XSUB(j)  (1280 + 64 * (j))
#define XB_XGEN(j)  (2304 + 64 * (j))
#define XB_TOP      3328
#define XB_TOPGEN   3392
#define XCD_BAR_WORDS 3456
#define XB_SPIN_CAP (1u << 18)

__device__ __forceinline__ unsigned xb_ld(unsigned* p)              { return __hip_atomic_load(p, __ATOMIC_RELAXED, __HIP_MEMORY_SCOPE_AGENT); }
__device__ __forceinline__ unsigned xb_add(unsigned* p, unsigned v) { return __hip_atomic_fetch_add(p, v, __ATOMIC_RELAXED, __HIP_MEMORY_SCOPE_AGENT); }
__device__ __forceinline__ unsigned xb_xcc_id() { return (unsigned)__builtin_amdgcn_s_getreg((3 << 11) | 20) & 0xFu; }
#define XB_SPIN(cond, bar) do { unsigned _sp = 0; while (cond) { __builtin_amdgcn_s_sleep(1); \
    if ((++_sp & 255u) == 0u) { if (xb_ld(&(bar)[XB_TMO])) break; if (_sp > XB_SPIN_CAP) { atomicAdd(&(bar)[XB_TMO], 1u); break; } } } } while (0)

struct XcdBarrier {
    unsigned* bar; unsigned x;
    volatile LAS unsigned* st;
};

__device__ __forceinline__ XcdBarrier xcd_barrier_post(unsigned* bar, volatile LAS unsigned* st) {
    XcdBarrier b; b.bar = bar; b.x = xb_xcc_id(); b.st = st;
    if (threadIdx.x == 0) (void)xb_add(&bar[XB_XCNT(b.x)], 1u);
    return b;
}
__device__ __forceinline__ void xcd_barrier_complete(unsigned* bar, unsigned x, unsigned& nloc, unsigned& nx) {
    const unsigned G = gridDim.x * gridDim.y * gridDim.z;
    unsigned sum, cnt, mine, sp = 0u;
    for (;;) {
        sum = 0u; cnt = 0u; mine = 0u;
#pragma unroll
        for (unsigned j = 0; j < 16; ++j) { const unsigned c = xb_ld(&bar[XB_XCNT(j)]); sum += c; cnt += (c > 0u) ? 1u : 0u; mine = (j == x) ? c : mine; }
        if (sum == G) break;
        __builtin_amdgcn_s_sleep(1);
        if ((++sp & 255u) == 0u) { if (xb_ld(&bar[XB_TMO])) break; if (sp > XB_SPIN_CAP) { atomicAdd(&bar[XB_TMO], 1u); break; } }
    }
    nloc = mine > 0u ? mine : 1u; nx = cnt > 0u ? cnt : 1u;
}

__device__ __forceinline__ void xcd_barrier(const XcdBarrier& b) {
    asm volatile("s_waitcnt vmcnt(0)" ::: "memory");
    __syncthreads();
    if (threadIdx.x == 0) {
        unsigned* bar = b.bar;
        __builtin_amdgcn_s_waitcnt(0);
        unsigned nloc = b.st[0], nx = b.st[1];
        if (nloc == 0u) { xcd_barrier_complete(bar, b.x, nloc, nx); b.st[0] = nloc; b.st[1] = nx; }
        const unsigned old = xb_add(&bar[XB_XSUB(b.x)], 1u);
        const unsigned gen = old / nloc;
        if (old + 1u == (gen + 1u) * nloc) {
            __builtin_amdgcn_fence(__ATOMIC_RELEASE, "agent");
            asm volatile("s_waitcnt vmcnt(0)" ::: "memory");
            const unsigned og = xb_add(&bar[XB_TOP], 1u);
            const unsigned tg = og / nx;
            if (og + 1u == (tg + 1u) * nx) xb_add(&bar[XB_TOPGEN], 1u);
            else XB_SPIN(xb_ld(&bar[XB_TOPGEN]) == tg, bar);
            __builtin_amdgcn_fence(__ATOMIC_ACQUIRE, "agent");
            xb_add(&bar[XB_XGEN(b.x)], 1u);
            asm volatile("s_waitcnt vmcnt(0)" ::: "memory");
        } else {
            XB_SPIN(xb_ld(&bar[XB_XGEN(b.x)]) == gen, bar);
            __builtin_amdgcn_fence(__ATOMIC_ACQUIRE, "agent");
            asm volatile("s_waitcnt vmcnt(0)" ::: "memory");
        }
    }
    __syncthreads();
}

constexpr int NWAVES = 8, NTHREADS = 512, GRID = 256;
constexpr int SEQ = 16384, DM = 1024, FF = 3584, NEXP = 8, NMEM = 256;
constexpr int N_IN0 = 1408, N_IN0P = 1536, N_IN1 = 2560;
constexpr float RMS_EPS = 1e-5f, LOG2E = 1.4426950408889634f, LN2 = 0.6931471805599453f;
constexpr int MOE_CHUNK_TILES = 64, MOE_MAX_TILES = 136, MOE_MAX_SLOTS = MOE_MAX_TILES * 256;

constexpr size_t MiB = 1u << 20, KiB = 1u << 10;
constexpr size_t WS_CTL = 0, CTL_ZERO_BYTES = 64 * KiB;
constexpr size_t WS_MEMN = 1 * MiB;
constexpr size_t WS_MKV0 = WS_MEMN + 512 * KiB;
constexpr size_t WS_MKV1 = WS_MKV0 + 256 * KiB;
constexpr size_t WS_ROUTE = 2 * MiB;
constexpr size_t WS_GATES = WS_ROUTE + 64 * KiB;
constexpr size_t WS_SDEST = WS_GATES + 128 * KiB;
constexpr size_t WS_SGATE = WS_SDEST + 256 * KiB;
constexpr size_t WS_CNTWG = WS_SGATE + 256 * KiB;
constexpr size_t WS_META = WS_CNTWG + 16 * KiB;
constexpr size_t WS_LSE = 3 * MiB;
constexpr size_t WS_WIN0 = 4 * MiB;
constexpr size_t WS_WMKV0 = 7 * MiB, WS_WMKV1 = 8 * MiB;
constexpr size_t WS_WOUT0 = 9 * MiB;
constexpr size_t WS_WGU0 = 11 * MiB;
constexpr size_t WS_WD0 = 25 * MiB;
constexpr size_t WS_WIN1 = 32 * MiB;
constexpr size_t WS_WOUT1 = 37 * MiB;
constexpr size_t WS_HN = 38 * MiB;
constexpr size_t WS_WMGU = 70 * MiB;
constexpr size_t WS_WMD = 182 * MiB;
constexpr size_t WS_R = 238 * MiB;
constexpr size_t WS_P0 = WS_R, WS_CAT0 = WS_R + 48 * MiB, WS_HID0 = WS_R + 80 * MiB;
constexpr size_t WS_P1 = WS_R, WS_OG = WS_R + 80 * MiB, WS_CAT1 = WS_R + 130 * MiB;
constexpr size_t WS_XS = WS_R, WS_HIDM = WS_R + 68 * MiB;
constexpr size_t WS_PAIR = 4 * MiB;
constexpr size_t WS_END = 468 * MiB;
static_assert(WS_HIDM + (size_t)MOE_CHUNK_TILES * 256 * FF * 2 <= WS_END && WS_HID0 + (size_t)SEQ * FF * 2 <= WS_END && WS_CAT1 + (size_t)SEQ * 512 * 2 <= WS_END, "ws map");
static_assert(WS_PAIR + (size_t)2 * SEQ * DM * 2 <= WS_WMGU && WS_XS + (size_t)MOE_MAX_SLOTS * DM * 2 <= WS_HIDM && WS_OG + (size_t)3 * SEQ * 256 * 4 <= WS_CAT1, "ws map 2");
constexpr int CW_BAR = 4096;

constexpr int RING_OFF = 0, RING_BYTES = 131072;
constexpr int MISC_OFF = RING_BYTES + 320;
constexpr int LDS_BYTES = 147456;

__device__ __forceinline__ float wave_sum(float v) {
#pragma unroll
    for (int o = 1; o < 64; o <<= 1) v += __shfl_xor(v, o);
    return v;
}
__device__ __forceinline__ int wave_sum_i(int v) {
#pragma unroll
    for (int o = 1; o < 64; o <<= 1) v += __shfl_xor(v, o);
    return v;
}

struct Frame {
    LAS unsigned char* lds;
    volatile LAS unsigned* MISC;
    int tid, lane, wave, bid;
};

__device__ __forceinline__ void p0_transpose_item(const float* W, int K, int N, bf16* WT, int drow0, int k0, int n0, LAS float* scr, int lane) {
#pragma unroll 8
    for (int i = 0; i < 32; ++i) { const int kk = 2 * i + (lane >> 5); scr[kk * 33 + (lane & 31)] = W[(size_t)(k0 + kk) * N + n0 + (lane & 31)]; }
    LDS_WAIT(); asm volatile("" ::: "memory");
    const int c = lane & 7;
#pragma unroll
    for (int j = 0; j < 4; ++j) { const int n = (lane >> 3) + 8 * j; const LAS float* s = scr + (8 * c) * 33 + n;
        v4u o; o.x = pk2(s[0 * 33], s[1 * 33]); o.y = pk2(s[2 * 33], s[3 * 33]); o.z = pk2(s[4 * 33], s[5 * 33]); o.w = pk2(s[6 * 33], s[7 * 33]);
        *(GAS v4u*)(WT + (size_t)(drow0 + n) * K + k0 + 8 * c) = o; }
    LDS_WAIT(); asm volatile("" ::: "memory");
}
__device__ __forceinline__ void rms_row(const float* xrow, const float* gain, bf16* obf, int lane) {
    const GAS f32x4* xr = (const GAS f32x4*)xrow + lane; const GAS f32x4* gr = (const GAS f32x4*)gain + lane;
    f32x4 v[4]; float s = 0.f;
#pragma unroll
    for (int j = 0; j < 4; ++j) { v[j] = xr[64 * j]; s += (v[j].x * v[j].x + v[j].y * v[j].y) + (v[j].z * v[j].z + v[j].w * v[j].w); }
    const float rstd = 1.0f / sqrtf(wave_sum(s) * (1.0f / DM) + RMS_EPS);
    GAS unsigned long long* o8 = (GAS unsigned long long*)obf + lane;
#pragma unroll
    for (int j = 0; j < 4; ++j) { const f32x4 g = gr[64 * j]; const f32x4 y = v[j] * rstd * g;
        o8[64 * j] = (unsigned long long)pk2(y.x, y.y) | ((unsigned long long)pk2(y.z, y.w) << 32); }
}
__device__ __forceinline__ float bf2f(unsigned short b) { return __uint_as_float((unsigned)b << 16); }

namespace att {
typedef short s16x4 __attribute__((ext_vector_type(4)));
typedef short v4i16_t __attribute__((ext_vector_type(4)));
typedef float f32x16 __attribute__((ext_vector_type(16)));
typedef float f32x2_t __attribute__((ext_vector_type(2)));
typedef __bf16 bf16x2_t __attribute__((ext_vector_type(2)));
constexpr int KSTR = 144, KROWS = 384, K_OFF = 0, V_OFF = KROWS * KSTR, VPLANE = KROWS * 64, B_OFF = V_OFF + 2 * VPLANE, WS_OFF = B_OFF + 1024, ATT_LDS = WS_OFF + 1024;
static_assert(ATT_LDS <= RING_BYTES, "attention LDS");
constexpr float SCALE2 = 0.125f * LOG2E;
__device__ __forceinline__ int crow(int r, int hi) { return (r & 3) + 8 * (r >> 2) + 4 * hi; }
__device__ __forceinline__ unsigned cvtpk(float lo, float hi) { f32x2_t v = {lo, hi}; bf16x2_t b = __builtin_convertvector(v, bf16x2_t); return __builtin_bit_cast(unsigned, b); }
__device__ __forceinline__ s16x4 vtr(const LAS unsigned char* p) { return __builtin_bit_cast(s16x4, __builtin_amdgcn_ds_read_tr16_b64_v4i16((LAS v4i16_t*)p)); }
__device__ __forceinline__ int t5_bucket(int d) {
    if (d < 16) return d;
    const int large = 16 + (int)(logf((float)d / 16.0f) / logf(128.0f) * 16.0f);
    return large < 31 ? large : 31;
}
template <int NT, bool BAND, int NROWS, int OUTMODE>
__device__ __forceinline__ void attn_unit(LAS unsigned char* lds, int tid, const bf16* qg, long qpitch, const bf16* kg, const bf16* vg, long kvpitch,
                                          int mq0, int dil, int res, int kt_min, int maxd, const float* table, int bias_head, float sink2,
                                          bf16* ob, long opitch, float* of, float* lsep) {
    const int lane = tid & 63, wave = __builtin_amdgcn_readfirstlane(tid >> 6), r32 = lane & 31, hi = lane >> 5;
    {
        const int m0 = BAND ? mq0 - 128 : 0;
#pragma unroll
        for (int it = 0; it < NROWS * 8 / NTHREADS; ++it) { const int idx = tid + it * NTHREADS, row = idx >> 3, c = idx & 7; int m = m0 + row; m = m < 0 ? 0 : m;
            const long tok = (long)m * dil + res;
            const v4u kv = *(const GAS v4u*)(kg + tok * kvpitch + c * 8), vv = *(const GAS v4u*)(vg + tok * kvpitch + c * 8);
            *(LAS v4u*)(lds + K_OFF + row * KSTR + c * 16) = kv;
            *(LAS v4u*)(lds + V_OFF + (c >> 2) * VPLANE + row * 64 + (c & 3) * 16) = vv; }
        if (BAND) { if (tid < 191) { const int o = 159 - tid; float val = -1e30f;
                if (o >= 0 && o <= maxd) val = table[t5_bucket(o * dil) * 12 + bias_head] * LOG2E;
                ((LAS float*)(lds + B_OFF))[tid] = val; } }
    }
    const int mq = mq0 + 32 * wave + r32;
    const bf16* qp = qg + ((long)mq * dil + res) * qpitch + hi * 8;
    bf16x8 qr[4];
#pragma unroll
    for (int s = 0; s < 4; ++s) qr[s] = *(const GAS bf16x8*)(qp + 16 * s);
    __syncthreads();
    const int kt0 = BAND ? wave : 0;
    const LAS unsigned char* kb = lds + K_OFF + (32 * kt0 + r32) * KSTR + hi * 16;
    const LAS float* bl = (const LAS float*)(lds + B_OFF) + (31 - r32 + 4 * hi);
#define ATT_QK_TILE(t, S) do { f32x16 a_; _Pragma("unroll") for (int i_ = 0; i_ < 16; ++i_) a_[i_] = 0.f; \
        _Pragma("unroll") for (int s_ = 0; s_ < 4; ++s_) { const bf16x8 kf_ = *(const LAS bf16x8*)(kb + (t) * 32 * KSTR + s_ * 32); a_ = __builtin_amdgcn_mfma_f32_32x32x16_bf16(kf_, qr[s_], a_, 0, 0, 0); } \
        if (BAND) { const bool dead_ = (kt0 + (t)) < kt_min; \
            _Pragma("unroll") for (int i_ = 0; i_ < 16; ++i_) { const float s_ = fmaf(a_[i_], SCALE2, bl[32 * (t) + (i_ & 3) + 8 * (i_ >> 2)]); S[i_] = dead_ ? -1e30f : s_; } } \
        else { _Pragma("unroll") for (int i_ = 0; i_ < 16; ++i_) S[i_] = a_[i_] * SCALE2; } } while (0)
    float mx = -1e30f;
#pragma unroll 1
    for (int t = 0; t < NT; ++t) { f32x16 S; ATT_QK_TILE(t, S);
        float m0 = fmaxf(fmaxf(S[0], S[1]), fmaxf(S[2], S[3])), m1 = fmaxf(fmaxf(S[4], S[5]), fmaxf(S[6], S[7])), m2 = fmaxf(fmaxf(S[8], S[9]), fmaxf(S[10], S[11])), m3 = fmaxf(fmaxf(S[12], S[13]), fmaxf(S[14], S[15]));
        mx = fmaxf(mx, fmaxf(fmaxf(m0, m1), fmaxf(m2, m3))); }
    mx = fmaxf(mx, __shfl_xor(mx, 32)); mx = fmaxf(mx, sink2);
    float l = 0.f;
    f32x16 o0, o1;
#pragma unroll
    for (int i = 0; i < 16; ++i) { o0[i] = 0.f; o1[i] = 0.f; }
    {
        const int i16 = lane & 15, q4 = i16 >> 2, p4 = i16 & 3, blk16 = (lane >> 4) & 1;
        const LAS unsigned char* vb = lds + V_OFF + (32 * kt0 + 4 * hi + q4) * 64 + blk16 * 32 + p4 * 8;
#pragma unroll 1
        for (int t = 0; t < NT; ++t) { f32x16 S; ATT_QK_TILE(t, S);
#pragma unroll
            for (int i = 0; i < 16; ++i) { const float p = __builtin_amdgcn_exp2f(S[i] - mx); S[i] = p; l += p; }
#pragma unroll
            for (int s = 0; s < 2; ++s) {
                v4u pw; pw.x = cvtpk(S[8 * s + 0], S[8 * s + 1]); pw.y = cvtpk(S[8 * s + 2], S[8 * s + 3]); pw.z = cvtpk(S[8 * s + 4], S[8 * s + 5]); pw.w = cvtpk(S[8 * s + 6], S[8 * s + 7]);
                const bf16x8 pa = __builtin_bit_cast(bf16x8, pw);
                const LAS unsigned char* vp = vb + (32 * t + 16 * s) * 64;
                const s16x4 a0 = vtr(vp), a1 = vtr(vp + 8 * 64), b0 = vtr(vp + VPLANE), b1 = vtr(vp + VPLANE + 8 * 64);
                const bf16x8 v0 = __builtin_shufflevector(a0, a1, 0, 1, 2, 3, 4, 5, 6, 7), v1 = __builtin_shufflevector(b0, b1, 0, 1, 2, 3, 4, 5, 6, 7);
                o0 = __builtin_amdgcn_mfma_f32_32x32x16_bf16(pa, v0, o0, 0, 0, 0);
                o1 = __builtin_amdgcn_mfma_f32_32x32x16_bf16(pa, v1, o1, 0, 0, 0);
            } }
    }
#undef ATT_QK_TILE
    l += __shfl_xor(l, 32); l += __builtin_amdgcn_exp2f(sink2 - mx);
    LAS float* wsf = (LAS float*)(lds + WS_OFF) + wave * 32;
    if (hi == 0) wsf[r32] = l;
    asm volatile("s_waitcnt lgkmcnt(0)" ::: "memory");
#pragma unroll
    for (int i = 0; i < 16; ++i) { const int qq = crow(i, hi); const float rl = 1.0f / wsf[qq];
        const long tok = (long)(mq0 + 32 * wave + qq) * dil + res;
        if (OUTMODE == 0) { bf16* op = ob + tok * opitch + r32; op[0] = (bf16)f2bf(o0[i] * rl); op[32] = (bf16)f2bf(o1[i] * rl); }
        else { float* op = of + tok * 256 + r32; op[0] = o0[i] * rl; op[32] = o1[i] * rl; } }
    if (OUTMODE == 2) { if (hi == 0) lsep[((long)mq * dil + res) * 4] = mx * LN2 + logf(l); }
    __syncthreads();
}
}

constexpr int PH_PRO = 0, PH_IN0 = 1, PH_ATT0 = 2, PH_OUT0 = 3, PH_NORM1 = 4, PH_GU0 = 5, PH_D0 = 6, PH_NORM2 = 7, PH_IN1 = 8, PH_ATT1 = 9, PH_COMB = 10, PH_OUT1 = 11,
              PH_ROUTE = 12, PH_SCAT = 13, PH_MOE = 14  , PH_FINAL = 20, N_PHASES = 21;
#ifndef MOE_NC
#define MOE_NC 3
#endif
#ifndef MK_PER_PHASE
#define MK_PER_PHASE 0
#endif
struct Args { const float* in[21]; float* out; unsigned char* ws; int ph_lo, ph_hi; };

__global__ void __launch_bounds__(NTHREADS, 2) fwd(Args args) {
    extern __shared__ __attribute__((aligned(16))) unsigned char lds[];
    Frame F;
    F.lds = (LAS unsigned char*)lds; F.MISC = (volatile LAS unsigned*)(F.lds + MISC_OFF);
    F.tid = threadIdx.x; F.lane = F.tid & 63; F.wave = __builtin_amdgcn_readfirstlane(F.tid >> 6); F.bid = blockIdx.x;
#define ws (args.ws)
    for (int u = F.tid; u < (LDS_BYTES - RING_BYTES) / 4; u += NTHREADS) ((LAS unsigned*)(F.lds + RING_BYTES))[u] = 0u;
    __syncthreads();
    XcdBarrier bar; bar.bar = (unsigned*)(ws + WS_CTL) + CW_BAR; bar.x = 0; bar.st = nullptr;
    if (!MK_PER_PHASE) bar = xcd_barrier_post((unsigned*)(ws + WS_CTL) + CW_BAR, F.MISC + 8);
    const int lo = args.ph_lo, hi = args.ph_hi;
#ifndef ONLY_PHASE
#define ONLY_PHASE -1
#endif
#define IN(k) ((ONLY_PHASE < 0 || ONLY_PHASE == (k) || (ONLY_PHASE == 14 && (k) >= 14 && (k) < 20)) && lo <= (k) && (k) < hi)
#define SEAM(k) do { if (IN(k) && IN((k) + 1)) xcd_barrier(bar); } while (0)
    const int gw = F.bid * NWAVES + F.wave, NGW = GRID * NWAVES;
#define x_ (args.in[0])
#define table_ (args.in[2])
#define norm_mix_ (args.in[4])
#define norm_ffn_ (args.in[5])
#define MEMN ((bf16*)(ws + WS_MEMN))
#define MKV0 ((bf16*)(ws + WS_MKV0))
#define MKV1 ((bf16*)(ws + WS_MKV1))
#define HN ((bf16*)(ws + WS_HN))
#define P0 ((bf16*)(ws + WS_P0))
#define CAT0 ((bf16*)(ws + WS_CAT0))
#define HID0 ((bf16*)(ws + WS_HID0))
#define P1 ((bf16*)(ws + WS_P1))
#define OG ((float*)(ws + WS_OG))
#define LSE ((float*)(ws + WS_LSE))
#define CAT1 ((bf16*)(ws + WS_CAT1))
#define XS ((bf16*)(ws + WS_XS))
#define HIDM ((bf16*)(ws + WS_HIDM))
#define PAIR ((bf16*)(ws + WS_PAIR))
#define ROUTE ((unsigned*)(ws + WS_ROUTE))
#define GATES ((float*)(ws + WS_GATES))
#define SDEST ((int*)(ws + WS_SDEST))
#define SGATE ((float*)(ws + WS_SGATE))
#define CNTWG ((int*)(ws + WS_CNTWG))
#define META ((int*)(ws + WS_META))
#define H (args.out)
    if (IN(PH_PRO)) {
        LAS float* scr = (LAS float*)(F.lds + RING_OFF + F.wave * 16384);
        int off = 0;
        for (int id = 0; id < 33; ++id) {
            const float* src; bf16* dst; int K, N, mode = 0;
            if (id < 9) {
                switch (id) {
                    case 0: src = args.in[7]; dst = (bf16*)(ws + WS_WIN0); K = DM; N = N_IN0; break;
                    case 1: src = args.in[9]; dst = (bf16*)(ws + WS_WMKV0); K = DM; N = 512; break;
                    case 2: src = args.in[10]; dst = (bf16*)(ws + WS_WOUT0); K = DM; N = DM; break;
                    case 3: src = args.in[14]; dst = (bf16*)(ws + WS_WGU0); K = DM; N = FF; mode = 1; break;
                    case 4: src = args.in[15]; dst = (bf16*)(ws + WS_WGU0); K = DM; N = FF; mode = 2; break;
                    case 5: src = args.in[16]; dst = (bf16*)(ws + WS_WD0); K = FF; N = DM; break;
                    case 6: src = args.in[11]; dst = (bf16*)(ws + WS_WIN1); K = DM; N = N_IN1; break;
                    case 7: src = args.in[12]; dst = (bf16*)(ws + WS_WMKV1); K = DM; N = 512; break;
                    default: src = args.in[13]; dst = (bf16*)(ws + WS_WOUT1); K = 512; N = DM; break;
                }
            } else {
                const int e = (id - 9) / 3, kind = (id - 9) % 3;
                if (kind == 0) { src = args.in[18] + (size_t)e * DM * FF; dst = (bf16*)(ws + WS_WMGU) + (size_t)e * 2 * FF * DM; K = DM; N = FF; mode = 1; }
                else if (kind == 1) { src = args.in[19] + (size_t)e * DM * FF; dst = (bf16*)(ws + WS_WMGU) + (size_t)e * 2 * FF * DM; K = DM; N = FF; mode = 2; }
                else { src = args.in[20] + (size_t)e * FF * DM; dst = (bf16*)(ws + WS_WMD) + (size_t)e * DM * FF; K = FF; N = DM; }
            }
            const int nnb = N / 32, nit = (K / 64) * nnb;
            int first = gw - off; if (first < 0) first += NGW;
            for (int it = first; it < nit; it += NGW) { const int kb = it / nnb, nb = it % nnb, n0 = 32 * nb;
                const int drow0 = mode == 0 ? n0 : 256 * (n0 >> 7) + (n0 & 127) + (mode == 2 ? 128 : 0);
                p0_transpose_item(src, K, N, dst, drow0, 64 * kb, n0, scr, F.lane); }
            off = (off + nit) % NGW;
        }
        { bf16* wz = (bf16*)(ws + WS_WIN0) + (size_t)N_IN0 * DM;
          for (int i = F.bid * NTHREADS + F.tid; i < (N_IN0P - N_IN0) * DM / 8; i += GRID * NTHREADS) ((GAS v4u*)wz)[i] = (v4u){0u, 0u, 0u, 0u}; }
        for (int m = gw; m < NMEM; m += NGW) rms_row(args.in[1] + (size_t)m * DM, args.in[3], MEMN + (size_t)m * DM, F.lane);
        for (int m = gw; m < SEQ; m += NGW) rms_row(x_ + (size_t)m * DM, norm_mix_, HN + (size_t)m * DM, F.lane);
    }
    SEAM(PH_PRO);

    if (IN(PH_IN0)) {
        { pg8::Gemm g{HN, (const bf16*)(ws + WS_WIN0), SEQ, N_IN0P, DM}; pg8::StaticOrder S; S.init(SEQ, N_IN0P, GRID, F.bid);
          pg8::EpiPlainBf16 E{P0, N_IN0P};
          pg8::gemm_phase<pg8::EpiPlainBf16, pg8::StaticOrder, true, true>(F.lds + RING_OFF, g, S, E); }
        { pg8::Gemm g{MEMN, (const bf16*)(ws + WS_WMKV0), NMEM, 512, DM}; pg8::StaticOrder S; S.init(NMEM, 512, GRID, (F.bid + 128) & 255);
          pg8::EpiPlainBf16 E{MKV0, 512};
          pg8::gemm_phase<pg8::EpiPlainBf16, pg8::StaticOrder, true, true>(F.lds + RING_OFF, g, S, E); }
        { pg8::Gemm g{MEMN, (const bf16*)(ws + WS_WMKV1), NMEM, 512, DM}; pg8::StaticOrder S; S.init(NMEM, 512, GRID, (F.bid + 126) & 255);
          pg8::EpiPlainBf16 E{MKV1, 512};
          pg8::gemm_phase<pg8::EpiPlainBf16, pg8::StaticOrder, true, true>(F.lds + RING_OFF, g, S, E); }
    }
    SEAM(PH_IN0);

    if (IN(PH_ATT0)) {
        for (int u = F.bid; u < 1024; u += GRID) {
            if (u < 768) { const int blk = u / 12, head = u % 12, kvh = head >> 2;
                att::attn_unit<5, true, 384, 0>(F.lds + RING_OFF, F.tid, P0 + 64 * head, N_IN0P, P0 + 768 + 64 * kvh, P0 + 960 + 64 * kvh, N_IN0P,
                                               256 * blk, 1, 0, blk == 0 ? 4 : 0, 127, table_, head, args.in[8][head] * LOG2E, CAT0 + 64 * head, DM, nullptr, nullptr);
            } else { const int v = u - 768, blk = v >> 2, mh = v & 3;
                att::attn_unit<8, false, 256, 0>(F.lds + RING_OFF, F.tid, P0 + 1152 + 64 * mh, N_IN0P, MKV0 + 64 * mh, MKV0 + 256 + 64 * mh, 512,
                                                256 * blk, 1, 0, 0, 0, table_, 0, -1e30f, CAT0 + 768 + 64 * mh, DM, nullptr, nullptr); }
        }
    }
    SEAM(PH_ATT0);

    if (IN(PH_OUT0)) {
        pg8::Gemm g{CAT0, (const bf16*)(ws + WS_WOUT0), SEQ, DM, DM}; pg8::StaticOrder S; S.init(SEQ, DM, GRID, F.bid);
        pg8::EpiResF32 E{x_, H, DM};
        pg8::gemm_phase<pg8::EpiResF32, pg8::StaticOrder, true, true>(F.lds + RING_OFF, g, S, E);
    }
    SEAM(PH_OUT0);

    if (IN(PH_NORM1)) { for (int m = gw; m < SEQ; m += NGW) rms_row(H + (size_t)m * DM, norm_ffn_, HN + (size_t)m * DM, F.lane); }
    SEAM(PH_NORM1);

    if (IN(PH_GU0)) {
        pg8::Gemm g{HN, (const bf16*)(ws + WS_WGU0), SEQ, 2 * FF, DM}; pg8::StaticOrder S; S.init(SEQ, 2 * FF, GRID, F.bid);
        pg8::EpiSwiglu E{HID0, FF, 1 << 20};
        pg8::gemm_phase<pg8::EpiSwiglu, pg8::StaticOrder, true, true>(F.lds + RING_OFF, g, S, E);
    }
    SEAM(PH_GU0);

    if (IN(PH_D0)) {
        pg8::Gemm g{HID0, (const bf16*)(ws + WS_WD0), SEQ, DM, FF}; pg8::StaticOrder S; S.init(SEQ, DM, GRID, F.bid);
        pg8::EpiResF32 E{H, H, DM};
        pg8::gemm_phase<pg8::EpiResF32, pg8::StaticOrder, true, true>(F.lds + RING_OFF, g, S, E);
    }
    SEAM(PH_D0);

    if (IN(PH_NORM2)) { for (int m = gw; m < SEQ; m += NGW) rms_row(H + (size_t)m * DM, norm_mix_ + DM, HN + (size_t)m * DM, F.lane); }
    SEAM(PH_NORM2);

    if (IN(PH_IN1)) {
        pg8::Gemm g{HN, (const bf16*)(ws + WS_WIN1), SEQ, N_IN1, DM}; pg8::StaticOrder S; S.init(SEQ, N_IN1, GRID, F.bid);
        pg8::EpiPlainBf16 E{P1, N_IN1};
        pg8::gemm_phase<pg8::EpiPlainBf16, pg8::StaticOrder, true, true>(F.lds + RING_OFF, g, S, E);
    }
    SEAM(PH_IN1);

    if (IN(PH_ATT1)) {
        for (int u = F.bid; u < 1024; u += GRID) {
            if (u < 768) { const int g = u >> 8, rem = u & 255, h = rem & 3, sb = rem >> 2, sh = 2 * g, dil = 1 << sh, res = sb & (dil - 1), blk = sb >> sh;
                att::attn_unit<5, true, 384, 2>(F.lds + RING_OFF, F.tid, P1 + 768 * g + 64 * h, N_IN1, P1 + 768 * g + 256 + 64 * h, P1 + 768 * g + 512 + 64 * h, N_IN1,
                                               256 * blk, dil, res, blk == 0 ? 4 : 0, 128, table_, 4 * g + h, -1e30f, nullptr, 0,
                                               OG + (size_t)g * SEQ * 256 + 64 * h, LSE + (size_t)g * SEQ * 4 + h);
            } else { const int v = u - 768, blk = v >> 2, mh = v & 3;
                att::attn_unit<8, false, 256, 0>(F.lds + RING_OFF, F.tid, P1 + 2304 + 64 * mh, N_IN1, MKV1 + 64 * mh, MKV1 + 256 + 64 * mh, 512,
                                                256 * blk, 1, 0, 0, 0, table_, 0, -1e30f, CAT1 + 256 + 64 * mh, 512, nullptr, nullptr); }
        }
    }
    SEAM(PH_ATT1);

    if (IN(PH_COMB)) {
        for (int t = gw; t < SEQ; t += NGW) { const int h = F.lane >> 4;
            const float l0 = LSE[(size_t)t * 4 + h], l1 = LSE[(size_t)(SEQ + t) * 4 + h], l2 = LSE[(size_t)(2 * SEQ + t) * 4 + h];
            const float M = fmaxf(l0, fmaxf(l1, l2)); const float w0 = __expf(l0 - M), w1 = __expf(l1 - M), w2 = __expf(l2 - M); const float inv = 1.0f / (w0 + w1 + w2);
            const f32x4 a = ((const GAS f32x4*)(OG + (size_t)t * 256))[F.lane], b = ((const GAS f32x4*)(OG + (size_t)(SEQ + t) * 256))[F.lane], c = ((const GAS f32x4*)(OG + (size_t)(2 * SEQ + t) * 256))[F.lane];
            const f32x4 o = (a * w0 + b * w1 + c * w2) * inv;
            ((GAS unsigned long long*)(CAT1 + (size_t)t * 512))[F.lane] = (unsigned long long)pk2(o.x, o.y) | ((unsigned long long)pk2(o.z, o.w) << 32); }
    }
    SEAM(PH_COMB);

    if (IN(PH_OUT1)) {
        pg8::Gemm g{CAT1, (const bf16*)(ws + WS_WOUT1), SEQ, DM, 512}; pg8::StaticOrder S; S.init(SEQ, DM, GRID, F.bid);
        pg8::EpiResF32 E{H, H, DM};
        pg8::gemm_phase<pg8::EpiResF32, pg8::StaticOrder, true, true>(F.lds + RING_OFF, g, S, E);
    }
    SEAM(PH_OUT1);

    if (IN(PH_ROUTE)) {
        LAS float* rt = (LAS float*)(F.lds + RING_OFF);
        LAS int* cntW = (LAS int*)(F.lds + RING_OFF + 32768);
        LAS int* rec = cntW + 64;
        for (int idx = F.tid; idx < 8192; idx += NTHREADS) rt[(idx & 7) * 1024 + (idx >> 3)] = args.in[17][idx];
        if (F.tid < MOE_MAX_SLOTS / GRID) SDEST[F.bid * (MOE_MAX_SLOTS / GRID) + F.tid] = -1;
        __syncthreads();
        int cw[8];
#pragma unroll
        for (int e = 0; e < 8; ++e) cw[e] = 0;
        for (int j = 0; j < 8; ++j) { const int tl = F.wave * 8 + j, t = F.bid * 64 + tl;
            const GAS f32x4* xr = (const GAS f32x4*)(H + (size_t)t * DM) + F.lane; const GAS f32x4* gr = (const GAS f32x4*)(norm_ffn_ + DM) + F.lane;
            f32x4 v[4]; float s = 0.f;
#pragma unroll
            for (int q = 0; q < 4; ++q) { v[q] = xr[64 * q]; s += (v[q].x * v[q].x + v[q].y * v[q].y) + (v[q].z * v[q].z + v[q].w * v[q].w); }
            const float rstd = 1.0f / sqrtf(wave_sum(s) * (1.0f / DM) + RMS_EPS);
            GAS unsigned long long* o8 = (GAS unsigned long long*)(HN + (size_t)t * DM) + F.lane;
#pragma unroll
            for (int q = 0; q < 4; ++q) { v[q] = v[q] * rstd * gr[64 * q]; o8[64 * q] = (unsigned long long)pk2(v[q].x, v[q].y) | ((unsigned long long)pk2(v[q].z, v[q].w) << 32); }
            float lg[8];
#pragma unroll
            for (int e = 0; e < 8; ++e) { float a = 0.f;
#pragma unroll
                for (int q = 0; q < 4; ++q) { const f32x4 r = *(const LAS f32x4*)(rt + e * 1024 + 4 * F.lane + 256 * q); a += (v[q].x * r.x + v[q].y * r.y) + (v[q].z * r.z + v[q].w * r.w); }
                lg[e] = wave_sum(a); }
            int i0 = 0; float v0 = lg[0];
#pragma unroll
            for (int e = 1; e < 8; ++e) if (lg[e] > v0) { v0 = lg[e]; i0 = e; }
            int i1 = -1; float v1 = -3.0e38f;
#pragma unroll
            for (int e = 0; e < 8; ++e) if (e != i0 && lg[e] > v1) { v1 = lg[e]; i1 = e; }
            const float ex = __expf(v1 - v0), g0 = 1.0f / (1.0f + ex), g1 = ex * g0;
            int lr0 = 0, lr1 = 0;
#pragma unroll
            for (int e = 0; e < 8; ++e) { lr0 = (e == i0) ? cw[e] : lr0; lr1 = (e == i1) ? cw[e] : lr1; cw[e] += ((e == i0) ? 1 : 0) + ((e == i1) ? 1 : 0); }
            if (F.lane == 0) { rec[tl * 4 + 0] = i0; rec[tl * 4 + 1] = i1; rec[tl * 4 + 2] = lr0; rec[tl * 4 + 3] = lr1; GATES[2 * t] = g0; GATES[2 * t + 1] = g1; }
        }
        if (F.lane == 0) {
#pragma unroll
            for (int e = 0; e < 8; ++e) cntW[F.wave * 8 + e] = cw[e]; }
        __syncthreads();
        if (F.tid < 64) { const int tl = F.tid, w = tl >> 3, e0 = rec[tl * 4], e1 = rec[tl * 4 + 1]; int r0 = rec[tl * 4 + 2], r1 = rec[tl * 4 + 3];
            for (int k = 0; k < w; ++k) { r0 += cntW[k * 8 + e0]; r1 += cntW[k * 8 + e1]; }
            ROUTE[F.bid * 64 + tl] = (unsigned)e0 | ((unsigned)e1 << 8) | ((unsigned)r0 << 16) | ((unsigned)r1 << 24);
        } else if (F.tid < 72) { const int e = F.tid - 64; int s = 0; for (int k = 0; k < 8; ++k) s += cntW[k * 8 + e]; CNTWG[F.bid * 8 + e] = s; }
        __syncthreads();
    }
    SEAM(PH_ROUTE);

    if (IN(PH_SCAT)) {
        LAS int* tab = (LAS int*)(F.lds + RING_OFF);
        LAS int* tot = tab + 2048;
        for (int idx = F.tid; idx < 2048; idx += NTHREADS) tab[idx] = CNTWG[idx];
        __syncthreads();
        { const int e = F.wave; int s = 0, b = 0;
#pragma unroll
          for (int q = 0; q < 4; ++q) { const int wg = F.lane + 64 * q, c = tab[wg * 8 + e]; s += c; b += (wg < F.bid) ? c : 0; }
          s = wave_sum_i(s); b = wave_sum_i(b); if (F.lane == 0) { tot[e] = s; tot[8 + e] = b; } }
        __syncthreads();
        if (F.bid == 0 && F.tid == 0) { int tp = 0; META[0] = 0; for (int e = 0; e < 8; ++e) { tp += (tot[e] + 255) >> 8; META[e + 1] = tp; } }
        for (int j = 0; j < 8; ++j) { const int t = F.bid * 64 + F.wave * 8 + j; const unsigned rr = ROUTE[t];
#pragma unroll
            for (int k = 0; k < 2; ++k) { const int e = (rr >> (8 * k)) & 0xff, lr = (rr >> (16 + 8 * k)) & 0xff; int eb = 0;
#pragma unroll
                for (int q = 0; q < 8; ++q) eb += (q < e) ? ((tot[q] + 255) & ~255) : 0;
                const int slot = eb + tot[8 + e] + lr;
                const GAS v4u* src = (const GAS v4u*)(HN + (size_t)t * DM); GAS v4u* dst = (GAS v4u*)(XS + (size_t)slot * DM);
                dst[F.lane] = src[F.lane]; dst[F.lane + 64] = src[F.lane + 64];
                if (F.lane == 0) { SDEST[slot] = 2 * t + k; SGATE[slot] = GATES[2 * t + k]; } }
        }
        __syncthreads();
    }
    SEAM(PH_SCAT);

    if (lo <= PH_MOE + 5 && hi > PH_MOE) {
        if (F.tid < 9) ((LAS int*)(F.lds + MISC_OFF))[16 + F.tid] = META[F.tid];
        __syncthreads();
    }
    _Pragma("unroll") for (int c = 0; c < MOE_NC; ++c) {
        const LAS int* tp = (const LAS int*)(F.lds + MISC_OFF) + 16;
        const int T = tp[8], tile0 = c * MOE_CHUNK_TILES; int nT = T - tile0; nT = nT < 0 ? 0 : (nT > MOE_CHUNK_TILES ? MOE_CHUNK_TILES : nT);
        if (IN(PH_MOE + 2 * c)) {
            pg8::Gemm g{XS + (size_t)tile0 * 256 * DM, (const bf16*)(ws + WS_WMGU), 0, 0, DM}; pg8::MoeOrder<28> S; S.init(nT, F.bid, tile0, tp);
            pg8::EpiSwiglu E{HIDM, FF, 28};
            pg8::gemm_phase<pg8::EpiSwiglu, pg8::MoeOrder<28>, true, true>(F.lds + RING_OFF, g, S, E);
        }
        SEAM(PH_MOE + 2 * c);
        if (IN(PH_MOE + 2 * c + 1)) {
            pg8::Gemm g{HIDM, (const bf16*)(ws + WS_WMD), 0, 0, FF}; pg8::MoeOrder<4> S; S.init(nT, F.bid, tile0, tp);
            pg8::EpiMoeDown E{PAIR, SDEST, SGATE, tile0};
            pg8::gemm_phase<pg8::EpiMoeDown, pg8::MoeOrder<4>, true, true>(F.lds + RING_OFF, g, S, E);
        }
        SEAM(PH_MOE + 2 * c + 1);
    }

    if (IN(PH_FINAL)) {
        for (int t = gw; t < SEQ; t += NGW) {
            GAS f32x4* xr = (GAS f32x4*)(H + (size_t)t * DM) + F.lane; const GAS f32x4* gr = (const GAS f32x4*)args.in[6] + F.lane;
            const GAS unsigned long long* pa = (const GAS unsigned long long*)(PAIR + (size_t)(2 * t) * DM) + F.lane; const GAS unsigned long long* pb = pa + DM / 4;
            f32x4 v[4]; float s = 0.f;
#pragma unroll
            for (int q = 0; q < 4; ++q) { const unsigned long long a = pa[64 * q], b = pb[64 * q];
                f32x4 y = xr[64 * q];
                y.x += bf2f((unsigned short)a) + bf2f((unsigned short)b); y.y += bf2f((unsigned short)(a >> 16)) + bf2f((unsigned short)(b >> 16));
                y.z += bf2f((unsigned short)(a >> 32)) + bf2f((unsigned short)(b >> 32)); y.w += bf2f((unsigned short)(a >> 48)) + bf2f((unsigned short)(b >> 48));
                v[q] = y; s += (y.x * y.x + y.y * y.y) + (y.z * y.z + y.w * y.w); }
            const float rstd = 1.0f / sqrtf(wave_sum(s) * (1.0f / DM) + RMS_EPS);
#pragma unroll
            for (int q = 0; q < 4; ++q) xr[64 * q] = v[q] * rstd * gr[64 * q];
        }
    }
#undef IN
#undef SEAM
#undef ws
}

extern "C" void kernel_launch(void* const* d_in, const int* in_sizes, int n_in, void* d_out, int out_size, void* d_ws, size_t ws_size, hipStream_t stream) {
    static int ready = 0;
    if (ready == 0) {
        if (n_in != 21 || in_sizes[0] != SEQ * DM || out_size != SEQ * DM || ws_size < WS_END) { fprintf(stderr, "kernel_launch: unexpected shapes (n_in %d, in0 %d, out %d, ws %zu); nothing launched\n", n_in, n_in > 0 ? in_sizes[0] : -1, out_size, ws_size); ready = -1; return; }
        if (hipFuncSetAttribute((const void*)fwd, hipFuncAttributeMaxDynamicSharedMemorySize, LDS_BYTES) != hipSuccess) { fprintf(stderr, "kernel_launch: hipFuncSetAttribute failed\n"); ready = -1; return; }
        int per_cu = 0;
        if (hipOccupancyMaxActiveBlocksPerMultiprocessor(&per_cu, (const void*)fwd, NTHREADS, LDS_BYTES) != hipSuccess || per_cu < 1) fprintf(stderr, "kernel_launch: occupancy query reports %d workgroups per CU\n", per_cu);
        (void)hipGetLastError();
        ready = 1;
    }
    if (ready < 0) return;
    if (hipMemsetAsync((char*)d_ws + WS_CTL, 0, CTL_ZERO_BYTES, stream) != hipSuccess) { fprintf(stderr, "kernel_launch: memset failed\n"); return; }
    Args a{};
    for (int i = 0; i < 21; ++i) a.in[i] = (const float*)d_in[i];
    a.out = (float*)d_out; a.ws = (unsigned char*)d_ws;
#if MK_PER_PHASE
    for (int p = 0; p < N_PHASES; ++p) { a.ph_lo = p; a.ph_hi = p + 1; hipLaunchKernelGGL(fwd, dim3(GRID), dim3(NTHREADS), LDS_BYTES, stream, a); }
#else
    a.ph_lo = 0; a.ph_hi = N_PHASES;
    hipLaunchKernelGGL(fwd, dim3(GRID), dim3(NTHREADS), LDS_BYTES, stream, a);
#endif
    const hipError_t le = hipPeekAtLastError();
    if (le != hipSuccess) fprintf(stderr, "kernel_launch: launch failed: %s\n", hipGetErrorName(le));
}
```

```cpp
#include <hip/hip_runtime.h>
#include <cstdio>
#include <cstdint>
#include <cmath>
namespace pg8 {
#define PG8_LAS __attribute__((address_space(3)))
typedef unsigned short bf16_t;
typedef short bf16x8 __attribute__((ext_vector_type(8)));
typedef float f32x4 __attribute__((ext_vector_type(4)));
typedef unsigned u32x4 __attribute__((ext_vector_type(4)));
constexpr int BM = 256, BK = 64, HALF = 128, HTB = HALF * BK * 2  , STAGE_BYTES = 8 * HTB, NXCD = 8, WGM = 8;

__host__ __device__ __forceinline__ int lds_byte(int r, int c) { const int st = (r >> 4) * 2 + (c >> 5), rr = r & 15, cc = c & 31, ob = rr * 64 + cc * 2; return st * 1024 + (ob ^ (((ob >> 9) & 1) << 5)); }
__host__ __device__ __forceinline__ void stage_rc(int b, int& R, int& C) { const int st = b / 1024, sb = b % 1024, swz = sb ^ (((sb >> 9) & 1) << 5); R = (st >> 1) * 16 + swz / 64; C = (st & 1) * 32 + (swz % 64) / 2; }
__host__ __device__ __forceinline__ int perm32(int rho) { const int n = rho >> 4, i = rho & 15; return 8 * (i >> 2) + 4 * n + (i & 3); }

struct Unit { int pm, pn, ko; };
struct Gemm { const bf16_t* A; const bf16_t* Bt; int M, N, K; int nt; };

struct StaticOrder {
    int nM, nN, nwg, G, c;
    __host__ __device__ __forceinline__ void init(int M, int N, int G_, int c_) { nM = M / BM; nN = N / BM; nwg = nM * nN; G = G_; c = c_; }
    __host__ __device__ __forceinline__ bool next(int i, Unit& u) const {
        const long L = (long)i * G + c; if (L >= nwg) return false;
        int wgid = (int)L; { const int q = nwg / NXCD, r = nwg % NXCD, xcd = wgid % NXCD, off = wgid / NXCD; wgid = (xcd < r ? xcd * (q + 1) : r * (q + 1) + (xcd - r) * q) + off; }
        const int nig = WGM * nN, gid = wgid / nig, fm = gid * WGM, gsz = (nM - fm) < WGM ? (nM - fm) : WGM;
        u.pm = fm + ((wgid % nig) % gsz); u.pn = (wgid % nig) / gsz; u.ko = 0; return true;
    }
    __device__ __forceinline__ void a_ready(const Unit&) const {}
    __device__ __forceinline__ void done(const Unit&) const {}
};

typedef float f32x2 __attribute__((ext_vector_type(2)));
typedef __bf16 bf16x2_t __attribute__((ext_vector_type(2)));
__device__ __forceinline__ unsigned cvt_pk_bf16(float lo, float hi) { const f32x2 v = {lo, hi}; const bf16x2_t b = __builtin_convertvector(v, bf16x2_t); return __builtin_bit_cast(unsigned, b); }

typedef unsigned u32x2 __attribute__((ext_vector_type(2)));
struct EpiPlainBf16 {
    static constexpr bool PERM = true, AFTER_DRAIN = false, INIT_ACC = false;
    bf16_t* O; int ldc; unsigned smask; float sval; const PG8_LAS float* rt;
    __device__ __forceinline__ void operator()(const f32x4 (&acc)[2][2][4][2], const Unit& u, int wr, int wc, int fr, int fq) const {
        const int row0 = u.pm * BM + wr * 64 + fr, col0 = u.pn * BM + wc * 32 + 8 * fq;
        const float sc0 = ((smask >> (2 * u.pn)) & 1u) ? sval : 1.0f, sc1 = ((smask >> (2 * u.pn + 1)) & 1u) ? sval : 1.0f;
#pragma unroll
        for (int ai = 0; ai < 2; ++ai)
#pragma unroll
            for (int m = 0; m < 4; ++m) { bf16_t* rowp = O + (size_t)(row0 + ai * HALF + m * 16) * ldc + col0;
                const float rs = rt ? rt[ai * HALF + wr * 64 + m * 16 + fr] : 1.0f;
#pragma unroll
                for (int bj = 0; bj < 2; ++bj) { const float sc = (bj ? sc1 : sc0) * rs; const f32x4 v0 = acc[ai][bj][m][0] * sc, v1 = acc[ai][bj][m][1] * sc;
                    u32x4 w; w.x = cvt_pk_bf16(v0[0], v0[1]); w.y = cvt_pk_bf16(v0[2], v0[3]); w.z = cvt_pk_bf16(v1[0], v1[1]); w.w = cvt_pk_bf16(v1[2], v1[3]);
                    *(u32x4*)(rowp + bj * HALF) = w; } }
    }
};
__device__ __forceinline__ float row_rstd(const float* ss, int row) { const f32x4 p = *(const f32x4*)(ss + (size_t)row * 4); return 1.0f / sqrtf(((p[0] + p[1]) + (p[2] + p[3])) * (1.0f / 1024.0f) + 1e-5f); }
struct EpiResF32 {
    static constexpr bool PERM = true, AFTER_DRAIN = false, INIT_ACC = true;
    const float* base; const bf16_t* bbase; float* out; int ldc; bf16_t* hb; float* ss; int lp_off;
    __device__ __forceinline__ void init(f32x4 (&acc)[2][2][4][2], const Unit& u, int wr, int wc, int fr, int fq) const {
        const int col0 = u.pn * BM + wc * 32 + 8 * fq;
#pragma unroll
        for (int ai = 0; ai < 2; ++ai)
#pragma unroll
            for (int m = 0; m < 4; ++m) { const size_t off = (size_t)(u.pm * BM + ai * HALF + wr * 64 + m * 16 + fr) * ldc + col0;
#pragma unroll
                for (int bj = 0; bj < 2; ++bj) {
                    if (base) {
#pragma unroll
                        for (int n = 0; n < 2; ++n) acc[ai][bj][m][n] = *(const f32x4*)(base + off + bj * HALF + 4 * n);
                    } else { const u32x4 w = *(const u32x4*)(bbase + off + bj * HALF);
                        acc[ai][bj][m][0] = (f32x4){__builtin_bit_cast(float, w.x << 16), __builtin_bit_cast(float, w.x & 0xffff0000u), __builtin_bit_cast(float, w.y << 16), __builtin_bit_cast(float, w.y & 0xffff0000u)};
                        acc[ai][bj][m][1] = (f32x4){__builtin_bit_cast(float, w.z << 16), __builtin_bit_cast(float, w.z & 0xffff0000u), __builtin_bit_cast(float, w.w << 16), __builtin_bit_cast(float, w.w & 0xffff0000u)}; } } }
    }
    __device__ __forceinline__ void operator()(const f32x4 (&acc)[2][2][4][2], const Unit& u, int wr, int wc, int fr, int fq) const {
        const int col0 = u.pn * BM + wc * 32 + 8 * fq; PG8_LAS float* lp = (PG8_LAS float*)(size_t)lp_off;
#pragma unroll
        for (int ai = 0; ai < 2; ++ai)
#pragma unroll
            for (int m = 0; m < 4; ++m) { const int rl = ai * HALF + wr * 64 + m * 16 + fr; const size_t off = (size_t)(u.pm * BM + rl) * ldc + col0; float s = 0.f;
#pragma unroll
                for (int bj = 0; bj < 2; ++bj) { const f32x4 v0 = acc[ai][bj][m][0], v1 = acc[ai][bj][m][1];
                    if (out) { *(f32x4*)(out + off + bj * HALF) = v0; *(f32x4*)(out + off + bj * HALF + 4) = v1; }
                    if (hb) { if (ss) s += ((v0[0] * v0[0] + v0[1] * v0[1]) + (v0[2] * v0[2] + v0[3] * v0[3])) + ((v1[0] * v1[0] + v1[1] * v1[1]) + (v1[2] * v1[2] + v1[3] * v1[3]));
                        u32x4 w; w.x = cvt_pk_bf16(v0[0], v0[1]); w.y = cvt_pk_bf16(v0[2], v0[3]); w.z = cvt_pk_bf16(v1[0], v1[1]); w.w = cvt_pk_bf16(v1[2], v1[3]); *(u32x4*)(hb + off + bj * HALF) = w; } }
                if (ss) { s += __shfl_xor(s, 16); s += __shfl_xor(s, 32); if (fq == 0) lp[rl * 4 + wc] = s; } }
        if (ss) { asm volatile("s_waitcnt lgkmcnt(0)" ::: "memory"); __builtin_amdgcn_s_barrier(); asm volatile("" ::: "memory");
            const int tid = threadIdx.x;
            if (tid < 256) { const f32x4 p = *(const PG8_LAS f32x4*)(lp + tid * 4); ss[(size_t)(u.pm * BM + tid) * 4 + u.pn] = (p[0] + p[1]) + (p[2] + p[3]); } }
    }
};
__device__ __forceinline__ float silu_mul(float g, float u) { return g * __builtin_amdgcn_rcpf(1.0f + __builtin_amdgcn_exp2f(g * -1.4426950408889634f)) * u; }
__device__ __forceinline__ f32x2 silu_mul2(f32x2 g, f32x2 u, float c1, float k) {
    const f32x2 a = g * c1; f32x2 e; e[0] = __builtin_amdgcn_exp2f(a[0]); e[1] = __builtin_amdgcn_exp2f(a[1]);
    const f32x2 kk = {k, k}; const f32x2 d = __builtin_elementwise_fma(e, kk, kk); f32x2 r; r[0] = __builtin_amdgcn_rcpf(d[0]); r[1] = __builtin_amdgcn_rcpf(d[1]);
    return (g * u) * r;
}
struct EpiSwiglu {
    static constexpr bool PERM = true, AFTER_DRAIN = false, INIT_ACC = false;
    bf16_t* O; int ldc; int pn_mod; const PG8_LAS float* rt;
    __device__ __forceinline__ void operator()(const f32x4 (&acc)[2][2][4][2], const Unit& u, int wr, int wc, int fr, int fq) const {
        const int row0 = u.pm * BM + wr * 64 + fr, col0 = (u.pn % pn_mod) * HALF + wc * 32 + 8 * fq;
#pragma unroll
        for (int ai = 0; ai < 2; ++ai)
#pragma unroll
            for (int m = 0; m < 4; ++m) { bf16_t* rowp = O + (size_t)(row0 + ai * HALF + m * 16) * ldc + col0;
                const float rs = rt ? rt[ai * HALF + wr * 64 + m * 16 + fr] : 1.0f, c1 = rs * -1.4426950408889634f, k = __builtin_amdgcn_rcpf(rs * rs);
                const f32x4 g0 = acc[ai][0][m][0], g1 = acc[ai][0][m][1], u0 = acc[ai][1][m][0], u1 = acc[ai][1][m][1];
                const f32x2 o0 = silu_mul2(g0.xy, u0.xy, c1, k), o1 = silu_mul2(g0.zw, u0.zw, c1, k), o2 = silu_mul2(g1.xy, u1.xy, c1, k), o3 = silu_mul2(g1.zw, u1.zw, c1, k);
                u32x4 w; w.x = cvt_pk_bf16(o0[0], o0[1]); w.y = cvt_pk_bf16(o1[0], o1[1]); w.z = cvt_pk_bf16(o2[0], o2[1]); w.w = cvt_pk_bf16(o3[0], o3[1]);
                *(u32x4*)rowp = w; }
    }
};
struct EpiMoeDown {
    static constexpr bool PERM = true, AFTER_DRAIN = false, INIT_ACC = false;
    bf16_t* O; const PG8_LAS int* dtab; const PG8_LAS float* gtab; mutable int ui;
    __device__ __forceinline__ void operator()(const f32x4 (&acc)[2][2][4][2], const Unit& u, int wr, int wc, int fr, int fq) const {
        const int rl0 = ui * BM + wr * 64 + fr, col0 = (u.pn & 3) * BM + wc * 32 + 8 * fq;
#pragma unroll
        for (int ai = 0; ai < 2; ++ai)
#pragma unroll
            for (int m = 0; m < 4; ++m) { const int rl = rl0 + ai * HALF + m * 16; const int d = dtab[rl];
                if (d >= 0) { const float gt = gtab[rl]; bf16_t* rowp = O + (size_t)d * 1024 + col0;
#pragma unroll
                    for (int bj = 0; bj < 2; ++bj) { const f32x4 v0 = acc[ai][bj][m][0] * gt, v1 = acc[ai][bj][m][1] * gt;
                        u32x4 w; w.x = cvt_pk_bf16(v0[0], v0[1]); w.y = cvt_pk_bf16(v0[2], v0[3]); w.z = cvt_pk_bf16(v1[0], v1[1]); w.w = cvt_pk_bf16(v1[2], v1[3]);
                        *(u32x4*)(rowp + bj * HALF) = w; } } }
        ++ui;
    }
};
typedef int i32x8 __attribute__((ext_vector_type(8)));
typedef int i32x4v __attribute__((ext_vector_type(4)));
__device__ __forceinline__ i32x8 cat8(bf16x8 lo, bf16x8 hi) { const i32x4v a = __builtin_bit_cast(i32x4v, lo), b = __builtin_bit_cast(i32x4v, hi); return __builtin_shufflevector(a, b, 0, 1, 2, 3, 4, 5, 6, 7); }
__device__ __forceinline__ unsigned pk4_fp8(float a, float b, float c, float d) { int w = 0; w = __builtin_amdgcn_cvt_pk_fp8_f32(a, b, w, false); w = __builtin_amdgcn_cvt_pk_fp8_f32(c, d, w, true); return (unsigned)w; }
struct EpiSwigluF8 {
    static constexpr bool PERM = true, AFTER_DRAIN = false, INIT_ACC = false;
    unsigned char* O; int ldc; float sc;
    __device__ __forceinline__ void operator()(const f32x4 (&acc)[2][2][4][2], const Unit& u, int wr, int wc, int fr, int fq) const {
        const int row0 = u.pm * BM + wr * 64 + fr, col0 = (u.pn % 28) * HALF + wc * 32 + 8 * fq;
#pragma unroll
        for (int ai = 0; ai < 2; ++ai)
#pragma unroll
            for (int m = 0; m < 4; ++m) { unsigned char* rowp = O + (size_t)(row0 + ai * HALF + m * 16) * ldc + col0;
                const float c1 = sc * -1.4426950408889634f, k = 1.0f / (sc * sc);
                const f32x4 g0 = acc[ai][0][m][0], g1 = acc[ai][0][m][1], u0 = acc[ai][1][m][0], u1 = acc[ai][1][m][1];
                const f32x2 o0 = silu_mul2(g0.xy, u0.xy, c1, k), o1 = silu_mul2(g0.zw, u0.zw, c1, k), o2 = silu_mul2(g1.xy, u1.xy, c1, k), o3 = silu_mul2(g1.zw, u1.zw, c1, k);
                u32x2 w; w.x = pk4_fp8(o0[0], o0[1], o1[0], o1[1]); w.y = pk4_fp8(o2[0], o2[1], o3[0], o3[1]);
                *(u32x2*)rowp = w; }
    }
};
template <int NN> struct MoeOrder {
    int nx, nq, base, j, h0; const PG8_LAS int* tp;
    __device__ __forceinline__ void init(int T, int c, const PG8_LAS int* tp_) { const int x = c & 7; j = c >> 3; base = (x * T) >> 3; nx = (((x + 1) * T) >> 3) - base; nq = nx * NN; tp = tp_; h0 = (nx + 1) >> 1; }
    __device__ __forceinline__ bool next(int i, Unit& u) const {
        const int q = i * 32 + j; if (q >= nq) return false;
        int pn, pm;
        if (NN == 4) { pn = q & 3; pm = base + (q >> 2); }
        else { const int s0 = h0 * NN, blk = q >= s0 ? 1 : 0, ql = q - (blk ? s0 : 0), rows = blk ? nx - h0 : h0;
            pn = ql / rows; pm = base + (blk ? h0 : 0) + (ql - pn * rows); }
        int e = 0;
#pragma unroll
        for (int k = 1; k < 8; ++k) e += (pm >= tp[k]) ? 1 : 0;
        u.pm = pm; u.pn = e * NN + pn; u.ko = 0; return true;
    }
    __device__ __forceinline__ void a_ready(const Unit&) const {}
    __device__ __forceinline__ void done(const Unit&) const {}
};
struct SplitKOrder {
    int nsub, c; const PG8_LAS int* tp;
    __device__ __forceinline__ void init(int T, int c_, const PG8_LAS int* tp_) { nsub = T > 128 ? (T - 128) * 28 : 0; c = c_; tp = tp_; }
    __device__ __forceinline__ bool next(int i, Unit& u) const {
        if (i != 0 || c >= nsub) return false;
        const int lt = c / 28, rem = c - lt * 28, pn = rem / 7, s = rem - pn * 7, pm = 128 + lt; int e = 0;
#pragma unroll
        for (int k = 1; k < 8; ++k) e += (pm >= tp[k]) ? 1 : 0;
        u.pm = pm; u.pn = e * 4 + pn; u.ko = s * 512; return true;
    }
    __device__ __forceinline__ void a_ready(const Unit&) const {}
    __device__ __forceinline__ void done(const Unit&) const {}
};
struct EpiPartF32 {
    static constexpr bool PERM = false, AFTER_DRAIN = false, INIT_ACC = false;
    float* part;
    __device__ __forceinline__ void operator()(const f32x4 (&acc)[2][2][4][2], const Unit& u, int wr, int wc, int fr, int fq) const {
        float* tile = part + (size_t)(((u.pm - 128) * 4 + (u.pn & 3)) * 7 + u.ko / 512) * 65536 + wc * 32 + 4 * fq;
#pragma unroll
        for (int ai = 0; ai < 2; ++ai)
#pragma unroll
            for (int m = 0; m < 4; ++m) { float* rowp = tile + (ai * HALF + wr * 64 + m * 16 + fr) * 256;
#pragma unroll
                for (int bj = 0; bj < 2; ++bj)
#pragma unroll
                    for (int n = 0; n < 2; ++n) *(f32x4*)(rowp + bj * HALF + n * 16) = acc[ai][bj][m][n]; }
    }
};

template <bool F8> struct Frag;
template <> struct Frag<false> { struct A { bf16x8 k[2]; };
    static __device__ __forceinline__ void load(A& d, const PG8_LAS unsigned char* p) { d.k[0] = *(const PG8_LAS bf16x8*)p; d.k[1] = *(const PG8_LAS bf16x8*)(p + 1024); }
    static __device__ __forceinline__ void mma(f32x4& acc, const A& b, const A& a) { acc = __builtin_amdgcn_mfma_f32_16x16x32_bf16(b.k[0], a.k[0], acc, 0, 0, 0); acc = __builtin_amdgcn_mfma_f32_16x16x32_bf16(b.k[1], a.k[1], acc, 0, 0, 0); } };
template <> struct Frag<true> { typedef i32x8 A;
    static __device__ __forceinline__ void load(A& d, const PG8_LAS unsigned char* p) { const i32x4v lo = *(const PG8_LAS i32x4v*)p, hi = *(const PG8_LAS i32x4v*)(p + 1024); d = __builtin_shufflevector(lo, hi, 0, 1, 2, 3, 4, 5, 6, 7); }
    static __device__ __forceinline__ void mma(f32x4& acc, const A& b, const A& a) {
        asm volatile("v_mfma_scale_f32_16x16x128_f8f6f4 %0, %1, %2, %0, %3, %3 op_sel_hi:[0,0,0]" : "+v"(acc) : "v"(b), "v"(a), "v"(0x7f7f7f7f)); } };
template <class Epi, class Sched, bool ALIGN_EPI = false, bool SP2 = false, bool F8 = false>
__device__ __forceinline__ void gemm_phase(PG8_LAS unsigned char* lds, const Gemm g, const Sched& S, const Epi& E) {
    int tid_ = threadIdx.x; asm volatile("" : "+v"(tid_));
    const int tid = tid_, wid = __builtin_amdgcn_readfirstlane(tid >> 6), lane = tid & 63, wr = wid >> 2, wc = wid & 3, fr = lane & 15, fq = lane >> 4;
    const int K = g.K, nt = g.nt ? g.nt : K / BK;
    unsigned voffA[2], voffB[2];
#pragma unroll
    for (int i = 0; i < 2; ++i) { int R, C; stage_rc(tid * 16 + i * 8192, R, C); const int Rb = Epi::PERM ? ((R & ~31) + perm32(R & 31)) : R;
        voffA[i] = (unsigned)(R * K + C) * 2u; voffB[i] = (unsigned)(Rb * K + C) * 2u; }
    const size_t kstep = (size_t)(BK * 2);
    const size_t hstep = (size_t)HALF * K * 2;
    const size_t tstep = 2 * hstep;
    const unsigned ldsw = (unsigned)wid * 1024u;
    const int aoff = lds_byte(wr * 64 + fr, fq * 8), boff = lds_byte(wc * 32 + fr, fq * 8);
#define PG8_SA(b, h) (((b) * 2 + (h)) * HTB)
#define PG8_SB(b, h) ((4 + (b) * 2 + (h)) * HTB)
#define PG8_STAGE(bufoff, gbase, voff) do { _Pragma("unroll") for (int _i = 0; _i < 2; ++_i) \
        __builtin_amdgcn_global_load_lds((const unsigned*)((const char*)(gbase) + (voff)[_i]), (PG8_LAS unsigned*)(lds + (bufoff) + ldsw + _i * 8192), 16, 0, 0); } while (0)
#define PG8_LDA(dst, b, h) do { _Pragma("unroll") for (int m = 0; m < 4; ++m) Frag<F8>::load(dst[m], lds + PG8_SA(b, h) + aoff + m * 2048); } while (0)
#define PG8_LDB(dst, b, h) do { _Pragma("unroll") for (int n = 0; n < 2; ++n) Frag<F8>::load(dst[n], lds + PG8_SB(b, h) + boff + n * 2048); } while (0)
#define PG8_MMA(ai, bj, At, Bt) do { __builtin_amdgcn_s_setprio(1); _Pragma("unroll") for (int m = 0; m < 4; ++m) _Pragma("unroll") for (int n = 0; n < 2; ++n) Frag<F8>::mma(acc[ai][bj][m][n], Bt[n], At[m]); \
        __builtin_amdgcn_s_setprio(0); } while (0)
#define PG8_WAIT_V(n) asm volatile("s_waitcnt vmcnt(" #n ")" ::: "memory")
#define PG8_WAIT_L(n) asm volatile("s_waitcnt lgkmcnt(" #n ")" ::: "memory")
#define PG8_BAR __builtin_amdgcn_s_barrier()
#define PG8_SCHED __builtin_amdgcn_sched_barrier(0)
    Unit cur, nxt; int ui = 0;
    if (!S.next(0, cur)) return;
    f32x4 acc[2][2][4][2];
    if constexpr (Epi::INIT_ACC) E.init(acc, cur, wr, wc, fr, fq);
    else {
#pragma unroll
    for (int a = 0; a < 2; ++a)
#pragma unroll
        for (int b = 0; b < 2; ++b)
#pragma unroll
            for (int m = 0; m < 4; ++m)
#pragma unroll
                for (int n = 0; n < 2; ++n) acc[a][b][m][n] = (f32x4){0.f, 0.f, 0.f, 0.f};
    }
    typename Frag<F8>::A At[4]; typename Frag<F8>::A B0[2], B1[2];
    const char* cA = (const char*)g.A + (size_t)cur.pm * tstep + cur.ko; const char* cB = (const char*)g.Bt + (size_t)cur.pn * tstep + cur.ko;
    S.a_ready(cur);
    if constexpr (SP2) {
        PG8_STAGE(PG8_SB(0, 0), cB, voffB); PG8_STAGE(PG8_SB(0, 1), cB + hstep, voffB); PG8_STAGE(PG8_SA(0, 0), cA, voffA); PG8_STAGE(PG8_SA(0, 1), cA + hstep, voffA);
        if (wr == 1) PG8_BAR;
        PG8_WAIT_V(2); PG8_BAR;
        PG8_STAGE(PG8_SB(1, 0), cB + kstep, voffB); PG8_STAGE(PG8_SA(1, 0), cA + kstep, voffA); PG8_STAGE(PG8_SB(1, 1), cB + hstep + kstep, voffB);
        PG8_WAIT_V(6); PG8_BAR;
    } else {
        PG8_STAGE(PG8_SB(0, 0), cB, voffB); PG8_STAGE(PG8_SA(0, 0), cA, voffA); PG8_STAGE(PG8_SB(0, 1), cB + hstep, voffB); PG8_STAGE(PG8_SA(0, 1), cA + hstep, voffA);
        if (wr == 1) PG8_BAR;
        PG8_WAIT_V(4); PG8_BAR;
        PG8_STAGE(PG8_SB(1, 0), cB + kstep, voffB); PG8_STAGE(PG8_SA(1, 0), cA + kstep, voffA); PG8_STAGE(PG8_SB(1, 1), cB + hstep + kstep, voffB);
        PG8_WAIT_V(6); PG8_BAR;
    }
    for (;;) {
        const bool has_next = S.next(ui + 1, nxt);
        const char* nA = has_next ? (const char*)g.A + (size_t)nxt.pm * tstep + nxt.ko : cA; const char* nB = has_next ? (const char*)g.Bt + (size_t)nxt.pn * tstep + nxt.ko : cB;
        for (int t = 0; t < nt; t += 2) {
            const bool last = (t == nt - 2);
            const char* a1 = cA + (size_t)(t + 1) * kstep;
            const char* a2 = last ? nA : cA + (size_t)(t + 2) * kstep; const char* b2 = last ? nB : cB + (size_t)(t + 2) * kstep;
            const char* a3 = a2 + kstep; const char* b3 = b2 + kstep;
            if (last && has_next) S.a_ready(nxt);
            if constexpr (SP2) {
            PG8_LDB(B0, 0, 0); PG8_LDB(B1, 0, 1); PG8_SCHED; PG8_LDA(At, 0, 0); PG8_STAGE(PG8_SA(1, 1), a1 + hstep, voffA);
            PG8_WAIT_V(8); PG8_WAIT_L(0); PG8_BAR; PG8_MMA(0, 0, At, B0); PG8_MMA(0, 1, At, B1); PG8_BAR; PG8_SCHED;
            PG8_LDA(At, 0, 1); PG8_STAGE(PG8_SB(0, 0), b2, voffB); PG8_STAGE(PG8_SB(0, 1), b2 + hstep, voffB); PG8_STAGE(PG8_SA(0, 0), a2, voffA);
            PG8_WAIT_V(8); PG8_WAIT_L(0); PG8_BAR; PG8_MMA(1, 0, At, B0); PG8_MMA(1, 1, At, B1); PG8_BAR; PG8_SCHED;
            PG8_LDB(B0, 1, 0); PG8_LDB(B1, 1, 1); PG8_SCHED; PG8_LDA(At, 1, 0); PG8_STAGE(PG8_SA(0, 1), a2 + hstep, voffA);
            PG8_WAIT_V(8); PG8_WAIT_L(0); PG8_BAR; PG8_MMA(0, 0, At, B0); PG8_MMA(0, 1, At, B1); PG8_BAR; PG8_SCHED;
            PG8_LDA(At, 1, 1); PG8_STAGE(PG8_SB(1, 0), b3, voffB); PG8_STAGE(PG8_SB(1, 1), b3 + hstep, voffB); PG8_STAGE(PG8_SA(1, 0), a3, voffA);
            PG8_WAIT_V(8); PG8_WAIT_L(0); PG8_BAR; PG8_MMA(1, 0, At, B0); PG8_MMA(1, 1, At, B1); PG8_BAR; PG8_SCHED;
            } else {
            PG8_LDB(B0, 0, 0); PG8_SCHED; PG8_LDA(At, 0, 0); PG8_STAGE(PG8_SA(1, 1), a1 + hstep, voffA);
            PG8_WAIT_L(8); PG8_BAR; PG8_WAIT_L(0); PG8_MMA(0, 0, At, B0); PG8_BAR; PG8_SCHED;
            PG8_LDB(B1, 0, 1); PG8_STAGE(PG8_SB(0, 0), b2, voffB);
            PG8_BAR; PG8_WAIT_L(0); PG8_MMA(0, 1, At, B1); PG8_BAR;
            PG8_LDA(At, 0, 1); PG8_STAGE(PG8_SA(0, 0), a2, voffA);
            PG8_BAR; PG8_WAIT_L(0); PG8_MMA(1, 0, At, B0); PG8_BAR; PG8_SCHED;
            PG8_STAGE(PG8_SB(0, 1), b2 + hstep, voffB);
            PG8_WAIT_V(6); PG8_BAR; PG8_MMA(1, 1, At, B1); PG8_BAR;
            PG8_LDB(B0, 1, 0); PG8_SCHED; PG8_LDA(At, 1, 0); PG8_STAGE(PG8_SA(0, 1), a2 + hstep, voffA);
            PG8_WAIT_L(8); PG8_BAR; PG8_WAIT_L(0); PG8_MMA(0, 0, At, B0); PG8_BAR; PG8_SCHED;
            PG8_LDB(B1, 1, 1); PG8_STAGE(PG8_SB(1, 0), b3, voffB);
            PG8_BAR; PG8_WAIT_L(0); PG8_MMA(0, 1, At, B1); PG8_BAR;
            PG8_LDA(At, 1, 1); PG8_STAGE(PG8_SA(1, 0), a3, voffA);
            PG8_BAR; PG8_WAIT_L(0); PG8_MMA(1, 0, At, B0); PG8_BAR; PG8_SCHED;
            PG8_STAGE(PG8_SB(1, 1), b3 + hstep, voffB);
            PG8_WAIT_V(6); PG8_BAR; PG8_MMA(1, 1, At, B1); PG8_BAR;
            }
        }
        if constexpr (ALIGN_EPI) { if (wr == 0) PG8_BAR; }
        if constexpr (F8) { asm volatile("s_nop 15\n\ts_nop 15" ::: "memory"); PG8_SCHED; }
        if constexpr (!Epi::AFTER_DRAIN) { E(acc, cur, wr, wc, fr, fq); S.done(cur); }
        if (!has_next) break;
#pragma unroll
        for (int a = 0; a < 2; ++a)
#pragma unroll
            for (int b = 0; b < 2; ++b)
#pragma unroll
                for (int m = 0; m < 4; ++m)
#pragma unroll
                    for (int n = 0; n < 2; ++n) acc[a][b][m][n] = (f32x4){0.f, 0.f, 0.f, 0.f};
        cur = nxt; cA = nA; cB = nB; ++ui;
        if constexpr (ALIGN_EPI) { if (wr == 1) PG8_BAR; }
    }
    PG8_WAIT_V(0);
    if constexpr (!ALIGN_EPI) { if (wr == 0) PG8_BAR; }
    PG8_BAR;
    if constexpr (Epi::AFTER_DRAIN) { E.fused(acc, cur, wr, wc, fr, fq, lds, wid, lane); S.done(cur); }
#undef PG8_SA
#undef PG8_SB
#undef PG8_STAGE
#undef PG8_LDA
#undef PG8_LDB
#undef PG8_MMA
#undef PG8_WAIT_V
#undef PG8_WAIT_L
#undef PG8_BAR
#undef PG8_SCHED
}
}

#define GAS __attribute__((address_space(1)))
#define LAS __attribute__((address_space(3)))
typedef unsigned short bf16;
typedef unsigned v4u __attribute__((ext_vector_type(4)));
typedef float f32x4 __attribute__((ext_vector_type(4)));
typedef short bf16x8 __attribute__((ext_vector_type(8)));
typedef GAS unsigned gu32;
typedef GAS unsigned long long gu64;
#define RLX_AGENT __ATOMIC_RELAXED, __HIP_MEMORY_SCOPE_AGENT
#define LDS_WAIT() asm volatile("s_waitcnt lgkmcnt(0)" ::: "memory")
#define VM_WAIT() asm volatile("s_waitcnt vmcnt(0)" ::: "memory")
__device__ __forceinline__ unsigned long long rt() { return __builtin_amdgcn_s_memrealtime(); }
__device__ __forceinline__ unsigned f2bf(float f) { unsigned u = __builtin_bit_cast(unsigned, f); return (u + 0x7fffu + ((u >> 16) & 1u)) >> 16; }
__device__ __forceinline__ unsigned pk2(float lo, float hi) { return f2bf(lo) | (f2bf(hi) << 16); }

#define XB_TMO      128
#define XB_XCNT(j)  (256  + 64 * (j))
#define XB_XSUB(j)  (1280 + 64 * (j))
#define XB_XGEN(j)  (2304 + 64 * (j))
#define XB_TOP      3328
#define XB_TOPGEN   3392
#define XCD_BAR_WORDS 3456
#define XB_SPIN_CAP (1u << 18)

__device__ __forceinline__ unsigned xb_ld(unsigned* p)              { return __hip_atomic_load(p, __ATOMIC_RELAXED, __HIP_MEMORY_SCOPE_AGENT); }
__device__ __forceinline__ unsigned xb_add(unsigned* p, unsigned v) { return __hip_atomic_fetch_add(p, v, __ATOMIC_RELAXED, __HIP_MEMORY_SCOPE_AGENT); }
__device__ __forceinline__ unsigned xb_xcc_id() { return (unsigned)__builtin_amdgcn_s_getreg((3 << 11) | 20) & 0xFu; }
#define XB_SPIN(cond, bar) do { unsigned _sp = 0; while (cond) { __builtin_amdgcn_s_sleep(1); \
    if ((++_sp & 255u) == 0u) { if (xb_ld(&(bar)[XB_TMO])) break; if (_sp > XB_SPIN_CAP) { atomicAdd(&(bar)[XB_TMO], 1u); break; } } } } while (0)

struct XcdBarrier {
    unsigned* bar; unsigned x;
    volatile LAS unsigned* st;
};

__device__ __forceinline__ XcdBarrier xcd_barrier_post(unsigned* bar, volatile LAS unsigned* st) {
    XcdBarrier b; b.bar = bar; b.x = xb_xcc_id(); b.st = st;
    if (threadIdx.x == 0) (void)xb_add(&bar[XB_XCNT(b.x)], 1u);
    return b;
}
__device__ __forceinline__ void xcd_barrier_complete(unsigned* bar, unsigned x, unsigned& nloc, unsigned& nx) {
    const unsigned G = gridDim.x * gridDim.y * gridDim.z;
    unsigned sum, cnt, mine, sp = 0u;
    for (;;) {
        sum = 0u; cnt = 0u; mine = 0u;
#pragma unroll
        for (unsigned j = 0; j < 16; ++j) { const unsigned c = xb_ld(&bar[XB_XCNT(j)]); sum += c; cnt += (c > 0u) ? 1u : 0u; mine = (j == x) ? c : mine; }
        if (sum == G) break;
        __builtin_amdgcn_s_sleep(1);
        if ((++sp & 255u) == 0u) { if (xb_ld(&bar[XB_TMO])) break; if (sp > XB_SPIN_CAP) { atomicAdd(&bar[XB_TMO], 1u); break; } }
    }
    nloc = mine > 0u ? mine : 1u; nx = cnt > 0u ? cnt : 1u;
}

__device__ __forceinline__ void xcd_barrier(const XcdBarrier& b) {
    asm volatile("s_waitcnt vmcnt(0)" ::: "memory");
    __syncthreads();
    if (threadIdx.x == 0) {
        unsigned* bar = b.bar;
        __builtin_amdgcn_s_waitcnt(0);
        unsigned nloc = b.st[0], nx = b.st[1];
        if (nloc == 0u) { xcd_barrier_complete(bar, b.x, nloc, nx); b.st[0] = nloc; b.st[1] = nx; }
        const unsigned old = xb_add(&bar[XB_XSUB(b.x)], 1u);
        const unsigned gen = old / nloc;
        if (old + 1u == (gen + 1u) * nloc) {
            __builtin_amdgcn_fence(__ATOMIC_RELEASE, "agent");
            asm volatile("s_waitcnt vmcnt(0)" ::: "memory");
            const unsigned og = xb_add(&bar[XB_TOP], 1u);
            const unsigned tg = og / nx;
            if (og + 1u == (tg + 1u) * nx) xb_add(&bar[XB_TOPGEN], 1u);
            else XB_SPIN(xb_ld(&bar[XB_TOPGEN]) == tg, bar);
            __builtin_amdgcn_fence(__ATOMIC_ACQUIRE, "agent");
            xb_add(&bar[XB_XGEN(b.x)], 1u);
            asm volatile("s_waitcnt vmcnt(0)" ::: "memory");
        } else {
            XB_SPIN(xb_ld(&bar[XB_XGEN(b.x)]) == gen, bar);
            __builtin_amdgcn_fence(__ATOMIC_ACQUIRE, "agent");
            asm volatile("s_waitcnt vmcnt(0)" ::: "memory");
        }
    }
    __syncthreads();
}

constexpr int NWAVES = 8, NTHREADS = 512, GRID = 256;
constexpr int SEQ = 16384, DM = 1024, FF = 3584, NEXP = 8, NMEM = 256;
constexpr int N_IN0 = 1408, N_IN0P = 1536, N_IN1 = 2560;
constexpr float RMS_EPS = 1e-5f, LOG2E = 1.4426950408889634f, LN2 = 0.6931471805599453f;
constexpr int MOE_MAX_TILES = 136, MOE_MAX_SLOTS = MOE_MAX_TILES * 256;

constexpr size_t MiB = 1u << 20, KiB = 1u << 10;
constexpr size_t WS_CTL = 0, CTL_ZERO_BYTES = 64 * KiB;
constexpr size_t WS_MEMN = 1 * MiB;
constexpr size_t WS_MKV0 = WS_MEMN + 512 * KiB;
constexpr size_t WS_MKV1 = WS_MKV0 + 256 * KiB;
constexpr size_t WS_ROUTE = 2 * MiB;
constexpr size_t WS_GATES = WS_ROUTE + 64 * KiB;
constexpr size_t WS_SDEST = WS_GATES + 128 * KiB;
constexpr size_t WS_SGATE = WS_SDEST + 256 * KiB;
constexpr size_t WS_CNTWG = WS_SGATE + 256 * KiB;
constexpr size_t WS_META = WS_CNTWG + 16 * KiB;
constexpr size_t WS_SLOTOF = WS_META + 16 * KiB;
constexpr size_t WS_LSE = 3 * MiB;
constexpr size_t WS_WIN0 = 4 * MiB;
constexpr size_t WS_WMKV0 = 7 * MiB, WS_WMKV1 = 8 * MiB;
constexpr size_t WS_WOUT0 = 9 * MiB;
constexpr size_t WS_WGU0 = 11 * MiB;
constexpr size_t WS_WD0 = 25 * MiB;
constexpr size_t WS_WIN1 = 32 * MiB;
constexpr size_t WS_WOUT1 = 37 * MiB;
constexpr size_t WS_HN = 38 * MiB;
constexpr size_t WS_WMGU = 70 * MiB;
constexpr size_t WS_WMD = 126 * MiB;
constexpr size_t WS_SS0 = 236 * MiB, WS_SS1 = 237 * MiB;
constexpr size_t WS_HN8 = 154 * MiB;
constexpr size_t WS_XS = 170 * MiB;
constexpr size_t WS_R = 238 * MiB;
constexpr size_t WS_P0 = WS_R, WS_CAT0 = WS_R + 48 * MiB, WS_HID0 = WS_R + 80 * MiB;
constexpr size_t WS_P1 = 154 * MiB, WS_OG = WS_R + 80 * MiB, WS_CAT1 = WS_R + 130 * MiB;
constexpr size_t WS_HIDM = 204 * MiB, WS_PAIR = 324 * MiB, WS_PART = 388 * MiB;
constexpr size_t WS_END = 468 * MiB;
static_assert(WS_HIDM + (size_t)MOE_MAX_SLOTS * FF <= WS_PAIR && WS_PAIR + (size_t)2 * SEQ * DM * 2 <= WS_PART && WS_PART + (size_t)224 * 65536 * 4 <= WS_END && WS_HID0 + (size_t)SEQ * FF * 2 <= WS_END && WS_CAT1 + (size_t)SEQ * 512 * 2 <= WS_END, "ws map");
static_assert(WS_WMD + (size_t)NEXP * DM * FF <= WS_HN8 && WS_XS + (size_t)MOE_MAX_SLOTS * DM <= WS_HIDM && WS_OG + (size_t)3 * SEQ * 256 * 4 <= WS_CAT1, "ws map 2");
constexpr int CW_BAR = 4096;
constexpr int CW_GRP = 8192, CW_XCC = 12288;
static_assert(WS_P1 + (size_t)SEQ * N_IN1 * 2 <= WS_R, "ws map 3");

constexpr int RING_OFF = 0, RING_BYTES = 131072;
constexpr int MISC_OFF = RING_BYTES + 320;
constexpr int LDS_BYTES = 147456;

__device__ __forceinline__ float wave_sum(float v) {
#pragma unroll
    for (int o = 1; o < 64; o <<= 1) v += __shfl_xor(v, o);
    return v;
}
__device__ __forceinline__ int wave_sum_i(int v) {
#pragma unroll
    for (int o = 1; o < 64; o <<= 1) v += __shfl_xor(v, o);
    return v;
}

struct Frame {
    LAS unsigned char* lds;
    volatile LAS unsigned* MISC;
    int tid, lane, wave, bid;
};

__device__ __forceinline__ void p0_transpose_item(const float* W, int K, int N, bf16* WT, int drow0, int k0, int n0, const float* gain, LAS float* scr, int lane) {
#pragma unroll 8
    for (int i = 0; i < 32; ++i) { const int kk = 2 * i + (lane >> 5); scr[kk * 33 + (lane & 31)] = __builtin_nontemporal_load(W + (size_t)(k0 + kk) * N + n0 + (lane & 31)); }
    LDS_WAIT(); asm volatile("" ::: "memory");
    const int c = lane & 7;
    f32x4 ga = {1.f, 1.f, 1.f, 1.f}, gb = ga;
    if (gain) { ga = *(const GAS f32x4*)(gain + k0 + 8 * c); gb = *(const GAS f32x4*)(gain + k0 + 8 * c + 4); }
#pragma unroll
    for (int j = 0; j < 4; ++j) { const int n = (lane >> 3) + 8 * j; const LAS float* s = scr + (8 * c) * 33 + n;
        v4u o; o.x = pk2(s[0 * 33] * ga.x, s[1 * 33] * ga.y); o.y = pk2(s[2 * 33] * ga.z, s[3 * 33] * ga.w); o.z = pk2(s[4 * 33] * gb.x, s[5 * 33] * gb.y); o.w = pk2(s[6 * 33] * gb.z, s[7 * 33] * gb.w);
        *(GAS v4u*)(WT + (size_t)(drow0 + n) * K + k0 + 8 * c) = o; }
    LDS_WAIT(); asm volatile("" ::: "memory");
}
__device__ __forceinline__ void p0_transpose_item_f8(const float* W, int K, int N, unsigned char* WT, int drow0, int k0, int n0, float scale, LAS float* scr, int lane) {
#pragma unroll 8
    for (int i = 0; i < 32; ++i) { const int kk = 2 * i + (lane >> 5); scr[kk * 33 + (lane & 31)] = __builtin_nontemporal_load(W + (size_t)(k0 + kk) * N + n0 + (lane & 31)); }
    LDS_WAIT(); asm volatile("" ::: "memory");
    const int c = lane & 7;
#pragma unroll
    for (int j = 0; j < 4; ++j) { const int n = (lane >> 3) + 8 * j; const LAS float* s = scr + (8 * c) * 33 + n;
        pg8::u32x2 o; o.x = pg8::pk4_fp8(s[0 * 33] * scale, s[1 * 33] * scale, s[2 * 33] * scale, s[3 * 33] * scale); o.y = pg8::pk4_fp8(s[4 * 33] * scale, s[5 * 33] * scale, s[6 * 33] * scale, s[7 * 33] * scale);
        __builtin_nontemporal_store(o, (GAS pg8::u32x2*)(WT + (size_t)(drow0 + n) * K + k0 + 8 * c)); }
    LDS_WAIT(); asm volatile("" ::: "memory");
}
__device__ __forceinline__ void xf8_load(const float* W, int N, int k0, int n0, int lane, f32x4 (&v)[8]) {
#pragma unroll
    for (int i = 0; i < 8; ++i) v[i] = __builtin_nontemporal_load((const GAS f32x4*)(W + (size_t)(k0 + 8 * i + (lane >> 3)) * N + n0 + 4 * (lane & 7)));
}
__device__ __forceinline__ void xf8_proc(const f32x4 (&v)[8], int K, unsigned char* WT, int drow0, int k0, float scale, LAS float* scr, int lane) {
#pragma unroll
    for (int i = 0; i < 8; ++i) { LAS float* d_ = scr + (8 * i + (lane >> 3)) * 33 + 4 * (lane & 7); d_[0] = v[i].x; d_[1] = v[i].y; d_[2] = v[i].z; d_[3] = v[i].w; }
    LDS_WAIT(); asm volatile("" ::: "memory");
    const int c = lane & 7;
#pragma unroll
    for (int j = 0; j < 4; ++j) { const int n = (lane >> 3) + 8 * j; const LAS float* s = scr + (8 * c) * 33 + n;
        pg8::u32x2 o; o.x = pg8::pk4_fp8(s[0 * 33] * scale, s[1 * 33] * scale, s[2 * 33] * scale, s[3 * 33] * scale); o.y = pg8::pk4_fp8(s[4 * 33] * scale, s[5 * 33] * scale, s[6 * 33] * scale, s[7 * 33] * scale);
        __builtin_nontemporal_store(o, (GAS pg8::u32x2*)(WT + (size_t)(drow0 + n) * K + k0 + 8 * c)); }
    LDS_WAIT(); asm volatile("" ::: "memory");
}
struct MoeItem { const float* W; unsigned char* WT; int K, N, drow0, k0, n0; float scale; };
template <bool NT = false>
__device__ __forceinline__ void rms_row(const float* xrow, const float* gain, bf16* obf, int lane) {
    const GAS f32x4* xr = (const GAS f32x4*)xrow + lane; const GAS f32x4* gr = (const GAS f32x4*)gain + lane;
    f32x4 v[4]; float s = 0.f;
#pragma unroll
    for (int j = 0; j < 4; ++j) { v[j] = NT ? __builtin_nontemporal_load(xr + 64 * j) : xr[64 * j]; s += (v[j].x * v[j].x + v[j].y * v[j].y) + (v[j].z * v[j].z + v[j].w * v[j].w); }
    const float rstd = 1.0f / sqrtf(wave_sum(s) * (1.0f / DM) + RMS_EPS);
    GAS unsigned long long* o8 = (GAS unsigned long long*)obf + lane;
#pragma unroll
    for (int j = 0; j < 4; ++j) { const f32x4 g = gr[64 * j]; const f32x4 y = v[j] * rstd * g;
        o8[64 * j] = (unsigned long long)pk2(y.x, y.y) | ((unsigned long long)pk2(y.z, y.w) << 32); }
}
__device__ __forceinline__ void raw_row(const float* xrow, bf16* obf, float* ss, int lane) {
    const GAS f32x4* xr = (const GAS f32x4*)xrow + lane;
    f32x4 v[4]; float s = 0.f;
#pragma unroll
    for (int j = 0; j < 4; ++j) { v[j] = __builtin_nontemporal_load(xr + 64 * j); s += (v[j].x * v[j].x + v[j].y * v[j].y) + (v[j].z * v[j].z + v[j].w * v[j].w); }
    s = wave_sum(s);
    GAS unsigned long long* o8 = (GAS unsigned long long*)obf + lane;
#pragma unroll
    for (int j = 0; j < 4; ++j) o8[64 * j] = (unsigned long long)pk2(v[j].x, v[j].y) | ((unsigned long long)pk2(v[j].z, v[j].w) << 32);
    if (lane == 0) *(GAS f32x4*)ss = (f32x4){s, 0.f, 0.f, 0.f};
}
__device__ __forceinline__ float bf2f(unsigned short b) { return __uint_as_float((unsigned)b << 16); }

constexpr int MOE_ITEMS = 24 * 1792;
constexpr int ATT_ITEMS = 2 * 4 * GRID * NWAVES;
__device__ __forceinline__ void moe_item(const float* wg, const float* wu, const float* wd, unsigned char* wsb, int it, MoeItem& I) {
    const int m = it / 1792, r = it - m * 1792, e = m / 3, kind = m - 3 * e;
    if (kind < 2) { const int kb = r / 112, nb = r - kb * 112, n0 = 32 * nb;
        I.W = (kind == 0 ? wg : wu) + (size_t)e * DM * FF; I.WT = wsb + WS_WMGU + (size_t)e * 2 * FF * DM; I.K = DM; I.N = FF; I.drow0 = 256 * (n0 >> 7) + (n0 & 127) + (kind == 1 ? 128 : 0); I.k0 = 64 * kb; I.n0 = n0; I.scale = 16.f; }
    else { const int kb = r >> 5, nb = r & 31, n0 = 32 * nb;
        I.W = wd + (size_t)e * FF * DM; I.WT = wsb + WS_WMD + (size_t)e * DM * FF; I.K = FF; I.N = DM; I.drow0 = n0; I.k0 = 64 * kb; I.n0 = n0; I.scale = 32.f; }
}
__device__ __forceinline__ void moe_convert_items(const float* wg, const float* wu, const float* wd, unsigned char* wsb, int lo, int hi, int worker, int nworkers, LAS float* scr, int lane) {
    for (int it = lo + worker; it < hi; it += nworkers) { const int m = it / 1792, r = it - m * 1792, e = m / 3, kind = m - 3 * e;
        if (kind < 2) { const int kb = r / 112, nb = r - kb * 112, n0 = 32 * nb;
            p0_transpose_item_f8((kind == 0 ? wg : wu) + (size_t)e * DM * FF, DM, FF, wsb + WS_WMGU + (size_t)e * 2 * FF * DM, 256 * (n0 >> 7) + (n0 & 127) + (kind == 1 ? 128 : 0), 64 * kb, n0, 16.f, scr, lane); }
        else { const int kb = r >> 5, nb = r & 31, n0 = 32 * nb;
            p0_transpose_item_f8(wd + (size_t)e * FF * DM, FF, DM, wsb + WS_WMD + (size_t)e * DM * FF, n0, 64 * kb, n0, 32.f, scr, lane); } }
}
__device__ __forceinline__ void moe_fill_items(const float* wg, const float* wu, const float* wd, unsigned char* wsb, int lo, int hi, int worker, int nworkers, LAS float* scr, int lane) {
    MoeItem I0, I1; f32x4 v0[8], v1[8];
    int it = lo + worker;
    if (it < hi) { moe_item(wg, wu, wd, wsb, it, I0); xf8_load(I0.W, I0.N, I0.k0, I0.n0, lane, v0); }
    for (; it < hi; it += 2 * nworkers) {
        const int it1 = it + nworkers, it2 = it1 + nworkers;
        if (it1 < hi) { moe_item(wg, wu, wd, wsb, it1, I1); xf8_load(I1.W, I1.N, I1.k0, I1.n0, lane, v1); }
        xf8_proc(v0, I0.K, I0.WT, I0.drow0, I0.k0, I0.scale, scr, lane);
        if (it2 < hi) { moe_item(wg, wu, wd, wsb, it2, I0); xf8_load(I0.W, I0.N, I0.k0, I0.n0, lane, v0); }
        if (it1 < hi) xf8_proc(v1, I1.K, I1.WT, I1.drow0, I1.k0, I1.scale, scr, lane);
    }
}
#ifndef FILL1
#define FILL1 10240
#endif
#ifndef FILL2
#define FILL2 10240
#endif
namespace att {
typedef short s16x4 __attribute__((ext_vector_type(4)));
typedef short v4i16_t __attribute__((ext_vector_type(4)));
typedef float f32x16 __attribute__((ext_vector_type(16)));
typedef float f32x2_t __attribute__((ext_vector_type(2)));
typedef __bf16 bf16x2_t __attribute__((ext_vector_type(2)));
constexpr int KSTR = 144, KROWS = 384, K_OFF = 0, V_OFF = KROWS * KSTR, VPLANE = KROWS * 64, B_OFF = V_OFF + 2 * VPLANE, BT_FLOATS = 192, WS_OFF = B_OFF + 12 * BT_FLOATS * 4, OST_OFF = WS_OFF + 1024, ATT_LDS = OST_OFF + NWAVES * 2048;
static_assert(ATT_LDS <= RING_BYTES, "attention LDS");
constexpr float SCALE2 = 0.125f * LOG2E;
constexpr float THR = 8.0f;
__device__ __forceinline__ int crow(int r, int hi) { return (r & 3) + 8 * (r >> 2) + 4 * hi; }
__device__ __forceinline__ unsigned cvtpk(float lo, float hi) { f32x2_t v = {lo, hi}; bf16x2_t b = __builtin_convertvector(v, bf16x2_t); return __builtin_bit_cast(unsigned, b); }
__device__ __forceinline__ s16x4 vtr(const LAS unsigned char* p) { return __builtin_bit_cast(s16x4, __builtin_amdgcn_ds_read_tr16_b64_v4i16((LAS v4i16_t*)p)); }
__device__ __forceinline__ float xhalf_max(float m) { auto rr = __builtin_amdgcn_permlane32_swap(__float_as_uint(m), __float_as_uint(m), false, false); return fmaxf(__uint_as_float(rr[0]), __uint_as_float(rr[1])); }
__device__ __forceinline__ float xhalf_sum(float m) { auto rr = __builtin_amdgcn_permlane32_swap(__float_as_uint(m), __float_as_uint(m), false, false); return __uint_as_float(rr[0]) + __uint_as_float(rr[1]); }
__device__ __forceinline__ int t5_bucket(int d) {
    if (d < 16) return d;
    const int large = 16 + (int)(logf((float)d / 16.0f) / logf(128.0f) * 16.0f);
    return large < 31 ? large : 31;
}
__device__ __forceinline__ void fill_bias_tables(LAS unsigned char* lds, int tid, const float* table, bool dilated) {
    for (int idx = tid; idx < 12 * BT_FLOATS; idx += NTHREADS) { const int h = idx / BT_FLOATS, j = idx - h * BT_FLOATS, o = 159 - j;
        const int dil = dilated ? (1 << (2 * (h >> 2))) : 1, maxd = dilated ? 128 : 127; float val = -1e30f;
        if (o >= 0 && o <= maxd) val = table[t5_bucket(o * dil) * 12 + h] * LOG2E;
        ((LAS float*)(lds + B_OFF))[idx] = val; }
}
struct UnitP { const bf16* qg; const bf16* kg; const bf16* vg; int qpitch, kvpitch, mq0, dil, res, nrows, m0; };
struct StageRegs { v4u k[6], v[6]; bf16x8 q[4]; };
__device__ __forceinline__ void issue_loads(const UnitP& P, StageRegs& R, int tid) {
    const int lane = tid & 63, wave = tid >> 6, r32 = lane & 31, hi = lane >> 5;
#pragma unroll
    for (int it = 0; it < 6; ++it) { const int idx = tid + it * NTHREADS, row = idx >> 3, c = idx & 7;
        if (row < P.nrows) { int m = P.m0 + row; m = m < 0 ? 0 : m; const long tok = (long)m * P.dil + P.res;
            R.k[it] = *(const GAS v4u*)(P.kg + tok * P.kvpitch + c * 8); R.v[it] = *(const GAS v4u*)(P.vg + tok * P.kvpitch + c * 8); } }
    const long qtok = (long)(P.mq0 + 32 * wave + r32) * P.dil + P.res;
#pragma unroll
    for (int s = 0; s < 4; ++s) R.q[s] = *(const GAS bf16x8*)(P.qg + qtok * P.qpitch + hi * 8 + 16 * s);
}
__device__ __forceinline__ void store_lds(LAS unsigned char* lds, const StageRegs& R, int nrows, int tid) {
#pragma unroll
    for (int it = 0; it < 6; ++it) { const int idx = tid + it * NTHREADS, row = idx >> 3, c = idx & 7;
        if (row < nrows) { *(LAS v4u*)(lds + K_OFF + row * KSTR + c * 16) = R.k[it]; *(LAS v4u*)(lds + V_OFF + (c >> 2) * VPLANE + row * 64 + (c & 3) * 16) = R.v[it]; } }
}
template <bool BAND, int OUTMODE>
__device__ __forceinline__ void compute(LAS unsigned char* lds, const bf16x8 (&qr)[4], int tid, int mq0, int dil, int res, int kt_min, int bias_tab, float sink2,
                                        bf16* ob, int opitch, float* lsep) {
    const int lane = tid & 63, wave = __builtin_amdgcn_readfirstlane(tid >> 6), r32 = lane & 31, hi = lane >> 5;
    constexpr int NT = BAND ? 5 : 8;
    const int kt0 = BAND ? wave : 0;
    int t0 = BAND ? kt_min - kt0 : 0; t0 = t0 < 0 ? 0 : t0;
    const LAS unsigned char* kb = lds + K_OFF + (32 * kt0 + r32) * KSTR + hi * 16;
    const LAS float* bl = (const LAS float*)(lds + B_OFF) + bias_tab * BT_FLOATS + (31 - r32 + 4 * hi);
    const int i16 = lane & 15, q4 = i16 >> 2, p4 = i16 & 3, blk16 = (lane >> 4) & 1;
    const LAS unsigned char* vb = lds + V_OFF + (32 * kt0 + 4 * hi + q4) * 64 + blk16 * 32 + p4 * 8;
    LAS float* wsf = (LAS float*)(lds + WS_OFF) + wave * 32;
    float mref = -1e20f, l = 0.f;
    f32x16 o0, o1;
#pragma unroll
    for (int i = 0; i < 16; ++i) { o0[i] = 0.f; o1[i] = 0.f; }
#pragma unroll 1
    for (int t = t0; t < NT; ++t) {
        f32x16 S;
        if (BAND) {
#pragma unroll
            for (int i = 0; i < 16; ++i) S[i] = bl[32 * t + (i & 3) + 8 * (i >> 2)];
        } else {
#pragma unroll
            for (int i = 0; i < 16; ++i) S[i] = 0.f;
        }
#pragma unroll
        for (int s = 0; s < 4; ++s) { const bf16x8 kf = *(const LAS bf16x8*)(kb + t * 32 * KSTR + s * 32); S = __builtin_amdgcn_mfma_f32_32x32x16_bf16(kf, qr[s], S, 0, 0, 0); }
        float m0 = fmaxf(fmaxf(S[0], S[1]), fmaxf(S[2], S[3])), m1 = fmaxf(fmaxf(S[4], S[5]), fmaxf(S[6], S[7])), m2 = fmaxf(fmaxf(S[8], S[9]), fmaxf(S[10], S[11])), m3 = fmaxf(fmaxf(S[12], S[13]), fmaxf(S[14], S[15]));
        const float mt = xhalf_max(fmaxf(fmaxf(m0, m1), fmaxf(m2, m3)));
        if (__any(mt > mref + THR)) {
            const float mnew = fmaxf(mref, mt), f = __builtin_amdgcn_exp2f(mref - mnew);
            mref = mnew; l *= f;
            if (hi == 0) wsf[r32] = f;
            asm volatile("s_waitcnt lgkmcnt(0)" ::: "memory");
#pragma unroll
            for (int i = 0; i < 16; ++i) { const float fi = wsf[crow(i, hi)]; o0[i] *= fi; o1[i] *= fi; }
        }
#pragma unroll
        for (int i = 0; i < 16; ++i) { const float p = __builtin_amdgcn_exp2f(S[i] - mref); S[i] = p; l += p; }
#pragma unroll
        for (int s = 0; s < 2; ++s) {
            v4u pw; pw.x = cvtpk(S[8 * s + 0], S[8 * s + 1]); pw.y = cvtpk(S[8 * s + 2], S[8 * s + 3]); pw.z = cvtpk(S[8 * s + 4], S[8 * s + 5]); pw.w = cvtpk(S[8 * s + 6], S[8 * s + 7]);
            const bf16x8 pa = __builtin_bit_cast(bf16x8, pw);
            const LAS unsigned char* vp = vb + (32 * t + 16 * s) * 64;
            const s16x4 a0 = vtr(vp), a1 = vtr(vp + 8 * 64), b0 = vtr(vp + VPLANE), b1 = vtr(vp + VPLANE + 8 * 64);
            const bf16x8 v0 = __builtin_shufflevector(a0, a1, 0, 1, 2, 3, 4, 5, 6, 7), v1 = __builtin_shufflevector(b0, b1, 0, 1, 2, 3, 4, 5, 6, 7);
            o0 = __builtin_amdgcn_mfma_f32_32x32x16_bf16(pa, v0, o0, 0, 0, 0);
            o1 = __builtin_amdgcn_mfma_f32_32x32x16_bf16(pa, v1, o1, 0, 0, 0);
        }
    }
    l = xhalf_sum(l); l += __builtin_amdgcn_exp2f(sink2 - mref);
    if (hi == 0) wsf[r32] = l;
    asm volatile("s_waitcnt lgkmcnt(0)" ::: "memory");
    float rl[16];
#pragma unroll
    for (int i = 0; i < 16; ++i) rl[i] = 1.0f / wsf[crow(i, hi)];
    LAS unsigned char* ost = lds + OST_OFF + wave * 2048;
#pragma unroll
    for (int half = 0; half < 2; ++half) {
#pragma unroll
        for (int i = 0; i < 16; ++i) *(LAS bf16*)(ost + crow(i, hi) * 64 + r32 * 2) = (bf16)f2bf((half ? o1[i] : o0[i]) * rl[i]);
        asm volatile("s_waitcnt lgkmcnt(0)" ::: "memory");
#pragma unroll
        for (int j = 0; j < 2; ++j) { const int idx = lane + 64 * j, row = idx >> 2, ch = idx & 3;
            const v4u val = *(const LAS v4u*)(ost + row * 64 + ch * 16);
            const long tok = (long)(mq0 + 32 * wave + row) * dil + res;
            *(GAS v4u*)(ob + tok * opitch + 32 * half + ch * 8) = val; }
        asm volatile("s_waitcnt lgkmcnt(0)" ::: "memory");
    }
    if (OUTMODE == 2) { if (hi == 0) lsep[((long)(mq0 + 32 * wave + r32) * dil + res) * 4] = mref * LN2 + logf(l); }
}
}

#ifndef GB_FULL
#define GB_FULL 0
#endif
__device__ __forceinline__ void group_barrier(unsigned* ctl, int grp, unsigned target, volatile LAS unsigned* lightw) {
    asm volatile("s_waitcnt vmcnt(0)" ::: "memory");
    __syncthreads();
    if (threadIdx.x == 0) {
        unsigned* w = ctl + CW_GRP + 64 * grp; unsigned* bar = ctl + CW_BAR;
        __builtin_amdgcn_s_waitcnt(0);
        if (GB_FULL || lightw[0] == 0u) { __builtin_amdgcn_fence(__ATOMIC_RELEASE, "agent"); asm volatile("s_waitcnt vmcnt(0)" ::: "memory"); }
        (void)xb_add(w, 1u);
        XB_SPIN(xb_ld(w) < target, bar);
        __builtin_amdgcn_fence(__ATOMIC_ACQUIRE, "agent");
        asm volatile("s_waitcnt vmcnt(0)" ::: "memory");
    }
    __syncthreads();
}

constexpr int PH_PRO = 0, PH_IN0 = 1, PH_ATT0 = 2, PH_OUT0 = 3, PH_GU0 = 4, PH_D0 = 5, PH_IN1 = 6, PH_ATT1 = 7, PH_COMB = 8, PH_OUT1 = 9,
              PH_ROUTE = 10, PH_SCAT = 11, PH_MOE = 12  , PH_FINAL = 14, N_PHASES = 15;
#ifndef MOE_NC
#define MOE_NC 3
#endif
#ifndef MK_PER_PHASE
#define MK_PER_PHASE 0
#endif
struct Args { const float* in[21]; float* out; unsigned char* ws; int ph_lo, ph_hi; };

__global__ void __launch_bounds__(NTHREADS, 2) fwd(Args args) {
    extern __shared__ __attribute__((aligned(16))) unsigned char lds[];
    Frame F;
    F.lds = (LAS unsigned char*)lds; F.MISC = (volatile LAS unsigned*)(F.lds + MISC_OFF);
    F.tid = threadIdx.x; F.lane = F.tid & 63; F.wave = __builtin_amdgcn_readfirstlane(F.tid >> 6); F.bid = blockIdx.x;
#define ws (args.ws)
    for (int u = F.tid; u < (LDS_BYTES - RING_BYTES) / 4; u += NTHREADS) ((LAS unsigned*)(F.lds + RING_BYTES))[u] = 0u;
    __syncthreads();
    XcdBarrier bar; bar.bar = (unsigned*)(ws + WS_CTL) + CW_BAR; bar.x = 0; bar.st = nullptr;
    if (!MK_PER_PHASE) bar = xcd_barrier_post((unsigned*)(ws + WS_CTL) + CW_BAR, F.MISC + 8);
    if (F.tid == 0) __hip_atomic_store((unsigned*)(ws + WS_CTL) + CW_XCC + F.bid, xb_xcc_id() + 1u, RLX_AGENT);
    const int lo = args.ph_lo, hi = args.ph_hi;
#ifndef ONLY_PHASE
#define ONLY_PHASE -1
#endif
#define IN(k) ((ONLY_PHASE < 0 || ONLY_PHASE == (k) || (ONLY_PHASE == 12 && (k) >= 12 && (k) < 14)) && lo <= (k) && (k) < hi)
#define SEAM(k) do { if (IN(k) && IN((k) + 1)) xcd_barrier(bar); } while (0)
    unsigned gseq = 0;
#define GSEAM(k) do { if (IN(k) && IN((k) + 1)) { ++gseq; group_barrier((unsigned*)(ws + WS_CTL), F.bid & 63, 4u * gseq, F.MISC + 10); } } while (0)
    const int gw = F.bid * NWAVES + F.wave, NGW = GRID * NWAVES;
    const int panel = 8 * (F.bid & 7) + ((F.bid >> 3) & 7), tok64 = 256 * panel + 64 * (F.bid >> 6);
#define x_ (args.in[0])
#define table_ (args.in[2])
#define norm_mix_ (args.in[4])
#define norm_ffn_ (args.in[5])
#define MEMN ((bf16*)(ws + WS_MEMN))
#define MKV0 ((bf16*)(ws + WS_MKV0))
#define MKV1 ((bf16*)(ws + WS_MKV1))
#define HN ((bf16*)(ws + WS_HN))
#define P0 ((bf16*)(ws + WS_P0))
#define CAT0 ((bf16*)(ws + WS_CAT0))
#define HID0 ((bf16*)(ws + WS_HID0))
#define P1 ((bf16*)(ws + WS_P1))
#define OG ((bf16*)(ws + WS_OG))
#define LSE ((float*)(ws + WS_LSE))
#define CAT1 ((bf16*)(ws + WS_CAT1))
#define XS (ws + WS_XS)
#define HIDM (ws + WS_HIDM)
#define HN8 (ws + WS_HN8)
#define PAIR ((bf16*)(ws + WS_PAIR))
#define ROUTE ((unsigned*)(ws + WS_ROUTE))
#define GATES ((float*)(ws + WS_GATES))
#define SDEST ((int*)(ws + WS_SDEST))
#define SGATE ((float*)(ws + WS_SGATE))
#define CNTWG ((int*)(ws + WS_CNTWG))
#define META ((int*)(ws + WS_META))
#define SLOTOF ((int*)(ws + WS_SLOTOF))
#define PART ((float*)(ws + WS_PART))
#define H (args.out)
#define SS0 ((float*)(ws + WS_SS0))
#define SS1 ((float*)(ws + WS_SS1))
    if (IN(PH_PRO)) {
        LAS float* scr = (LAS float*)(F.lds + RING_OFF + F.wave * 16384);
        int off = 0;
        for (int id = 0; id < 9; ++id) {
            const float* src; const float* gain = nullptr; bf16* dst = nullptr; int K, N, mode = 0;
            {
                switch (id) {
                    case 0: src = args.in[7]; dst = (bf16*)(ws + WS_WIN0); K = DM; N = N_IN0; gain = norm_mix_; break;
                    case 1: src = args.in[9]; dst = (bf16*)(ws + WS_WMKV0); K = DM; N = 512; break;
                    case 2: src = args.in[10]; dst = (bf16*)(ws + WS_WOUT0); K = DM; N = DM; break;
                    case 3: src = args.in[14]; dst = (bf16*)(ws + WS_WGU0); K = DM; N = FF; mode = 1; gain = norm_ffn_; break;
                    case 4: src = args.in[15]; dst = (bf16*)(ws + WS_WGU0); K = DM; N = FF; mode = 2; gain = norm_ffn_; break;
                    case 5: src = args.in[16]; dst = (bf16*)(ws + WS_WD0); K = FF; N = DM; break;
                    case 6: src = args.in[11]; dst = (bf16*)(ws + WS_WIN1); K = DM; N = N_IN1; gain = norm_mix_ + DM; break;
                    case 7: src = args.in[12]; dst = (bf16*)(ws + WS_WMKV1); K = DM; N = 512; break;
                    default: src = args.in[13]; dst = (bf16*)(ws + WS_WOUT1); K = 512; N = DM; break;
                }
            }
            const int nnb = N / 32, nit = (K / 64) * nnb;
            int first = gw - off; if (first < 0) first += NGW;
            for (int it = first; it < nit; it += NGW) { const int kb = it / nnb, nb = it % nnb, n0 = 32 * nb;
                const int drow0 = mode == 0 ? n0 : 256 * (n0 >> 7) + (n0 & 127) + (mode == 2 ? 128 : 0);
                p0_transpose_item(src, K, N, dst, drow0, 64 * kb, n0, gain, scr, F.lane); }
            off = (off + nit) % NGW;
        }
        moe_convert_items(args.in[18], args.in[19], args.in[20], ws, FILL1 + FILL2 + ATT_ITEMS, MOE_ITEMS, (gw + NGW - off) % NGW, NGW, scr, F.lane);
        { bf16* wz = (bf16*)(ws + WS_WIN0) + (size_t)N_IN0 * DM;
          for (int i = F.bid * NTHREADS + F.tid; i < (N_IN0P - N_IN0) * DM / 8; i += GRID * NTHREADS) ((GAS v4u*)wz)[i] = (v4u){0u, 0u, 0u, 0u}; }
        for (int m = gw; m < NMEM; m += NGW) rms_row(args.in[1] + (size_t)m * DM, args.in[3], MEMN + (size_t)m * DM, F.lane);
        for (int m = gw; m < SEQ; m += NGW) raw_row(x_ + (size_t)m * DM, HN + (size_t)m * DM, SS1 + (size_t)m * 4, F.lane);
    }
    SEAM(PH_PRO);
    if (IN(PH_PRO) && IN(PH_PRO + 1) && F.tid == 0) {
        unsigned* xc = (unsigned*)(ws + WS_CTL) + CW_XCC + (F.bid & 63); const unsigned a0 = xb_ld(xc), a1 = xb_ld(xc + 64), a2 = xb_ld(xc + 128), a3 = xb_ld(xc + 192);
        F.MISC[10] = (a0 != 0u && a0 == a1 && a0 == a2 && a0 == a3) ? 1u : 0u; }

    if (IN(PH_IN0)) {
        { pg8::Gemm g{HN, (const bf16*)(ws + WS_WIN0), SEQ, N_IN0P, DM, 0}; pg8::StaticOrder S; S.init(SEQ, N_IN0P, GRID, F.bid);
          LAS float* rtab = (LAS float*)(F.lds + MISC_OFF + 5120);
          { pg8::Unit uu; if (S.next(0, uu) && F.tid < 256) rtab[F.tid] = pg8::row_rstd(SS1, uu.pm * 256 + F.tid); }
          __syncthreads();
          pg8::EpiPlainBf16 E{P0, N_IN0P, 0x63Fu, att::SCALE2, rtab};
          pg8::gemm_phase<pg8::EpiPlainBf16, pg8::StaticOrder, true, true>(F.lds + RING_OFF, g, S, E); }
        { pg8::Gemm g{MEMN, (const bf16*)(ws + WS_WMKV0), NMEM, 512, DM, 0}; pg8::StaticOrder S; S.init(NMEM, 512, GRID, (F.bid + 128) & 255);
          pg8::EpiPlainBf16 E{MKV0, 512, 0u, 1.0f, nullptr};
          pg8::gemm_phase<pg8::EpiPlainBf16, pg8::StaticOrder, true, true>(F.lds + RING_OFF, g, S, E); }
        { pg8::Gemm g{MEMN, (const bf16*)(ws + WS_WMKV1), NMEM, 512, DM, 0}; pg8::StaticOrder S; S.init(NMEM, 512, GRID, (F.bid + 126) & 255);
          pg8::EpiPlainBf16 E{MKV1, 512, 0u, 1.0f, nullptr};
          pg8::gemm_phase<pg8::EpiPlainBf16, pg8::StaticOrder, true, true>(F.lds + RING_OFF, g, S, E); }
        if (F.bid >= 132) moe_fill_items(args.in[18], args.in[19], args.in[20], ws, 0, FILL1, (F.bid - 132) * NWAVES + F.wave, 124 * NWAVES, (LAS float*)(F.lds + RING_OFF + F.wave * 16384), F.lane);
    }
    SEAM(PH_IN0);

    if (IN(PH_ATT0)) {
        LAS unsigned char* al = F.lds + RING_OFF;
        att::fill_bias_tables(al, F.tid, table_, false);
        att::StageRegs R; att::UnitP Pn;
#define SWA_UNIT(i) (panel * 12 + 3 * (F.bid >> 6) + (i))
#define MK_UNIT(i, P) do { const int u_ = (i) < 3 ? SWA_UNIT(i) : panel * 4 + (F.bid >> 6) + 768; if ((i) < 3) { const int blk_ = u_ / 12, head_ = u_ % 12, kvh_ = head_ >> 2; \
            P.qg = P0 + 64 * head_; P.kg = P0 + 768 + 64 * kvh_; P.vg = P0 + 960 + 64 * kvh_; P.qpitch = N_IN0P; P.kvpitch = N_IN0P; P.mq0 = 256 * blk_; P.dil = 1; P.res = 0; P.nrows = 384; P.m0 = 256 * blk_ - 128; } \
          else { const int v_ = u_ - 768, blk_ = v_ >> 2, mh_ = v_ & 3; \
            P.qg = P0 + 1152 + 64 * mh_; P.kg = MKV0 + 64 * mh_; P.vg = MKV0 + 256 + 64 * mh_; P.qpitch = N_IN0P; P.kvpitch = 512; P.mq0 = 256 * blk_; P.dil = 1; P.res = 0; P.nrows = 256; P.m0 = 0; } } while (0)
        MK_UNIT(0, Pn); att::issue_loads(Pn, R, F.tid);
#pragma unroll
        for (int i = 0; i < 4; ++i) {
            const att::UnitP Pc = Pn;
            att::store_lds(al, R, Pc.nrows, F.tid);
            const bf16x8 qr[4] = {R.q[0], R.q[1], R.q[2], R.q[3]};
            asm volatile("s_waitcnt lgkmcnt(0)\n\ts_barrier" ::: "memory");
            if (i < 3) { MK_UNIT(i + 1, Pn); att::issue_loads(Pn, R, F.tid); }
            MoeItem CI; f32x4 cv[8];
            moe_item(args.in[18], args.in[19], args.in[20], ws, FILL1 + FILL2 + ((0 * 4 + i) * GRID + F.bid) * NWAVES + F.wave, CI); xf8_load(CI.W, CI.N, CI.k0, CI.n0, F.lane, cv);
            const int u = i < 3 ? SWA_UNIT(i) : panel * 4 + (F.bid >> 6) + 768;
            if (i < 3) { const int blk = u / 12, head = u % 12;
                att::compute<true, 0>(al, qr, F.tid, Pc.mq0, 1, 0, blk == 0 ? 4 : 0, head, args.in[8][head] * LOG2E, CAT0 + 64 * head, DM, nullptr); }
            else { const int mh = (u - 768) & 3;
                att::compute<false, 0>(al, qr, F.tid, Pc.mq0, 1, 0, 0, 0, -1e30f, CAT0 + 768 + 64 * mh, DM, nullptr); }
            asm volatile("s_waitcnt lgkmcnt(0)\n\ts_barrier" ::: "memory");
            xf8_proc(cv, CI.K, CI.WT, CI.drow0, CI.k0, CI.scale, (LAS float*)(al + F.wave * 8448), F.lane);
            asm volatile("s_waitcnt lgkmcnt(0)\n\ts_barrier" ::: "memory");
        }
#undef MK_UNIT
    }
    GSEAM(PH_ATT0);

    if (IN(PH_OUT0)) {
        pg8::Gemm g{CAT0, (const bf16*)(ws + WS_WOUT0), SEQ, DM, DM, 0}; pg8::StaticOrder S; S.init(SEQ, DM, GRID, F.bid);
        pg8::EpiResF32 E{nullptr, HN, nullptr, DM, HN, SS0, MISC_OFF + 1024};
        pg8::gemm_phase<pg8::EpiResF32, pg8::StaticOrder, true, true>(F.lds + RING_OFF, g, S, E);
    }
    GSEAM(PH_OUT0);

    if (IN(PH_GU0)) {
        pg8::Gemm g{HN, (const bf16*)(ws + WS_WGU0), SEQ, 2 * FF, DM, 0}; pg8::StaticOrder S; S.init(SEQ, 2 * FF, GRID, F.bid);
        LAS float* rtab = (LAS float*)(F.lds + MISC_OFF + 5120);
        { pg8::Unit uu; if (S.next(0, uu) && F.tid < 256) rtab[F.tid] = pg8::row_rstd(SS0, uu.pm * 256 + F.tid); }
        __syncthreads();
        pg8::EpiSwiglu E{HID0, FF, 1 << 20, rtab};
        pg8::gemm_phase<pg8::EpiSwiglu, pg8::StaticOrder, true, true>(F.lds + RING_OFF, g, S, E);
    }
    GSEAM(PH_GU0);

    if (IN(PH_D0)) {
        pg8::Gemm g{HID0, (const bf16*)(ws + WS_WD0), SEQ, DM, FF, 0}; pg8::StaticOrder S; S.init(SEQ, DM, GRID, F.bid);
        pg8::EpiResF32 E{nullptr, HN, nullptr, DM, HN, SS1, MISC_OFF + 1024};
        pg8::gemm_phase<pg8::EpiResF32, pg8::StaticOrder, true, true>(F.lds + RING_OFF, g, S, E);
    }
    GSEAM(PH_D0);

    if (IN(PH_IN1)) {
        pg8::Gemm g{HN, (const bf16*)(ws + WS_WIN1), SEQ, N_IN1, DM, 0}; pg8::StaticOrder S; S.init(SEQ, N_IN1, GRID, F.bid);
        LAS float* rtab = (LAS float*)(F.lds + MISC_OFF + 5120);
        { pg8::Unit uu; if (S.next(0, uu) && F.tid < 256) rtab[F.tid] = pg8::row_rstd(SS1, uu.pm * 256 + F.tid); }
        __syncthreads();
        pg8::EpiPlainBf16 E{P1, N_IN1, 0xC30C3u, att::SCALE2, rtab};
        pg8::gemm_phase<pg8::EpiPlainBf16, pg8::StaticOrder, true, true>(F.lds + RING_OFF, g, S, E);
        if (F.bid >= 128) moe_fill_items(args.in[18], args.in[19], args.in[20], ws, FILL1, FILL1 + FILL2, (F.bid - 128) * NWAVES + F.wave, 128 * NWAVES, (LAS float*)(F.lds + RING_OFF + F.wave * 16384), F.lane);
    }
    SEAM(PH_IN1);

    if (IN(PH_ATT1)) {
        LAS unsigned char* al = F.lds + RING_OFF;
        att::fill_bias_tables(al, F.tid, table_, true);
        att::StageRegs R; att::UnitP Pn;
#define MK_UNIT(i, P) do { if ((i) < 3) { const int g_ = (i), h_ = F.bid & 3, sb_ = F.bid >> 2, sh_ = 2 * g_, dil_ = 1 << sh_, res_ = sb_ & (dil_ - 1), blk_ = sb_ >> sh_; \
            P.qg = P1 + 768 * g_ + 64 * h_; P.kg = P1 + 768 * g_ + 256 + 64 * h_; P.vg = P1 + 768 * g_ + 512 + 64 * h_; P.qpitch = N_IN1; P.kvpitch = N_IN1; P.mq0 = 256 * blk_; P.dil = dil_; P.res = res_; P.nrows = 384; P.m0 = 256 * blk_ - 128; } \
          else { const int blk_ = F.bid >> 2, mh_ = F.bid & 3; \
            P.qg = P1 + 2304 + 64 * mh_; P.kg = MKV1 + 64 * mh_; P.vg = MKV1 + 256 + 64 * mh_; P.qpitch = N_IN1; P.kvpitch = 512; P.mq0 = 256 * blk_; P.dil = 1; P.res = 0; P.nrows = 256; P.m0 = 0; } } while (0)
        MK_UNIT(0, Pn); att::issue_loads(Pn, R, F.tid);
#pragma unroll
        for (int i = 0; i < 4; ++i) {
            const att::UnitP Pc = Pn;
            att::store_lds(al, R, Pc.nrows, F.tid);
            const bf16x8 qr[4] = {R.q[0], R.q[1], R.q[2], R.q[3]};
            asm volatile("s_waitcnt lgkmcnt(0)\n\ts_barrier" ::: "memory");
            if (i < 3) { MK_UNIT(i + 1, Pn); att::issue_loads(Pn, R, F.tid); }
            MoeItem CI; f32x4 cv[8];
            moe_item(args.in[18], args.in[19], args.in[20], ws, FILL1 + FILL2 + ((1 * 4 + i) * GRID + F.bid) * NWAVES + F.wave, CI); xf8_load(CI.W, CI.N, CI.k0, CI.n0, F.lane, cv);
            if (i < 3) { const int g = i, h = F.bid & 3;
                att::compute<true, 2>(al, qr, F.tid, Pc.mq0, Pc.dil, Pc.res, Pc.mq0 == 0 ? 4 : 0, 4 * g + h, -1e30f, OG + (size_t)g * SEQ * 256 + 64 * h, 256, LSE + (size_t)g * SEQ * 4 + h); }
            else { const int mh = F.bid & 3;
                att::compute<false, 0>(al, qr, F.tid, Pc.mq0, 1, 0, 0, 0, -1e30f, CAT1 + 256 + 64 * mh, 512, nullptr); }
            asm volatile("s_waitcnt lgkmcnt(0)\n\ts_barrier" ::: "memory");
            xf8_proc(cv, CI.K, CI.WT, CI.drow0, CI.k0, CI.scale, (LAS float*)(al + F.wave * 8448), F.lane);
            asm volatile("s_waitcnt lgkmcnt(0)\n\ts_barrier" ::: "memory");
        }
#undef MK_UNIT
    }
    SEAM(PH_ATT1);

    if (IN(PH_COMB)) {
        for (int t = tok64 + F.wave * 8; t < tok64 + F.wave * 8 + 8; ++t) { const int h = F.lane >> 4;
            const float l0 = LSE[(size_t)t * 4 + h], l1 = LSE[(size_t)(SEQ + t) * 4 + h], l2 = LSE[(size_t)(2 * SEQ + t) * 4 + h];
            const float M = fmaxf(l0, fmaxf(l1, l2)); const float w0 = __expf(l0 - M), w1 = __expf(l1 - M), w2 = __expf(l2 - M); const float inv = 1.0f / (w0 + w1 + w2);
            const unsigned long long ua = ((const GAS unsigned long long*)(OG + (size_t)t * 256))[F.lane], ub = ((const GAS unsigned long long*)(OG + (size_t)(SEQ + t) * 256))[F.lane], uc = ((const GAS unsigned long long*)(OG + (size_t)(2 * SEQ + t) * 256))[F.lane];
            const f32x4 a = {bf2f((unsigned short)ua), bf2f((unsigned short)(ua >> 16)), bf2f((unsigned short)(ua >> 32)), bf2f((unsigned short)(ua >> 48))};
            const f32x4 b = {bf2f((unsigned short)ub), bf2f((unsigned short)(ub >> 16)), bf2f((unsigned short)(ub >> 32)), bf2f((unsigned short)(ub >> 48))};
            const f32x4 c = {bf2f((unsigned short)uc), bf2f((unsigned short)(uc >> 16)), bf2f((unsigned short)(uc >> 32)), bf2f((unsigned short)(uc >> 48))};
            const f32x4 o = (a * w0 + b * w1 + c * w2) * inv;
            ((GAS unsigned long long*)(CAT1 + (size_t)t * 512))[F.lane] = (unsigned long long)pk2(o.x, o.y) | ((unsigned long long)pk2(o.z, o.w) << 32); }
    }
    GSEAM(PH_COMB);

    if (IN(PH_OUT1)) {
        pg8::Gemm g{CAT1, (const bf16*)(ws + WS_WOUT1), SEQ, DM, 512, 0}; pg8::StaticOrder S; S.init(SEQ, DM, GRID, F.bid);
        pg8::EpiResF32 E{nullptr, HN, nullptr, DM, HN, nullptr, 0};
        pg8::gemm_phase<pg8::EpiResF32, pg8::StaticOrder, true, true>(F.lds + RING_OFF, g, S, E);
    }
    GSEAM(PH_OUT1);

    v4u rowreg[8];
    if (IN(PH_ROUTE)) {
        LAS float* grt = (LAS float*)(F.lds + RING_OFF);
        LAS float* red = (LAS float*)(F.lds + RING_OFF + 32768) + F.wave * 2432;
        LAS int* rec = (LAS int*)(F.lds + RING_OFF + 32768 + NWAVES * 9728);
        { const float* gain = norm_ffn_ + DM;
          for (int idx = F.tid; idx < 8192; idx += NTHREADS) { const int k = idx >> 3; grt[(idx & 7) * 1024 + ((k >> 2) & 3) * 256 + (k >> 4) * 4 + (k & 3)] = args.in[17][idx] * gain[k]; } }
        if (F.tid < MOE_MAX_SLOTS / GRID) SDEST[F.bid * (MOE_MAX_SLOTS / GRID) + F.tid] = -1;
        __syncthreads();
        f32x4 gq[4];
#pragma unroll
        for (int q = 0; q < 4; ++q) gq[q] = ((const GAS f32x4*)(norm_ffn_ + DM))[4 * F.lane + q];
#pragma unroll 1
        for (int b = 0; b < 2; ++b) { const int tl0 = F.wave * 8 + 4 * b, t0 = tok64 + tl0;
            f32x4 v[4][4];
#pragma unroll
            for (int i = 0; i < 4; ++i) { const GAS v4u* hr = (const GAS v4u*)(HN + (size_t)(t0 + i) * DM) + 2 * F.lane; const v4u w0 = hr[0], w1 = hr[1];
                v[i][0] = (f32x4){__uint_as_float(w0.x << 16), __uint_as_float(w0.x & 0xffff0000u), __uint_as_float(w0.y << 16), __uint_as_float(w0.y & 0xffff0000u)};
                v[i][1] = (f32x4){__uint_as_float(w0.z << 16), __uint_as_float(w0.z & 0xffff0000u), __uint_as_float(w0.w << 16), __uint_as_float(w0.w & 0xffff0000u)};
                v[i][2] = (f32x4){__uint_as_float(w1.x << 16), __uint_as_float(w1.x & 0xffff0000u), __uint_as_float(w1.y << 16), __uint_as_float(w1.y & 0xffff0000u)};
                v[i][3] = (f32x4){__uint_as_float(w1.z << 16), __uint_as_float(w1.z & 0xffff0000u), __uint_as_float(w1.w << 16), __uint_as_float(w1.w & 0xffff0000u)}; }
#pragma unroll
            for (int i = 0; i < 4; ++i) { float s = 0.f;
#pragma unroll
                for (int q = 0; q < 4; ++q) s += (v[i][q].x * v[i][q].x + v[i][q].y * v[i][q].y) + (v[i][q].z * v[i][q].z + v[i][q].w * v[i][q].w);
                red[F.lane * 37 + 9 * i] = s; }
#pragma unroll 2
            for (int e = 0; e < 8; ++e) { f32x4 r[4];
#pragma unroll
                for (int q = 0; q < 4; ++q) r[q] = *(const LAS f32x4*)(grt + e * 1024 + 256 * q + 4 * F.lane);
#pragma unroll
                for (int i = 0; i < 4; ++i) { float a = 0.f;
#pragma unroll
                    for (int q = 0; q < 4; ++q) a += (v[i][q].x * r[q].x + v[i][q].y * r[q].y) + (v[i][q].z * r[q].z + v[i][q].w * r[q].w);
                    red[F.lane * 37 + 9 * i + 1 + e] = a; } }
            asm volatile("s_waitcnt lgkmcnt(0)" ::: "memory");
            if (F.lane < 36) { float s = 0.f;
#pragma unroll 8
                for (int l = 0; l < 64; ++l) s += red[l * 37 + F.lane];
                red[2368 + F.lane] = s; }
            asm volatile("s_waitcnt lgkmcnt(0)" ::: "memory");
#pragma unroll
            for (int i = 0; i < 4; ++i) { const float rstd = 1.0f / sqrtf(red[2368 + 9 * i] * (1.0f / DM) + RMS_EPS);
                const f32x4 y0 = v[i][0] * rstd * gq[0], y1 = v[i][1] * rstd * gq[1], y2 = v[i][2] * rstd * gq[2], y3 = v[i][3] * rstd * gq[3];
                const v4u pk = {pg8::pk4_fp8(y0.x, y0.y, y0.z, y0.w), pg8::pk4_fp8(y1.x, y1.y, y1.z, y1.w), pg8::pk4_fp8(y2.x, y2.y, y2.z, y2.w), pg8::pk4_fp8(y3.x, y3.y, y3.z, y3.w)};
                if (b == 0) rowreg[i] = pk; else rowreg[4 + i] = pk; }
            if (F.lane < 4) { const int i = F.lane; const float rstd = 1.0f / sqrtf(red[2368 + 9 * i] * (1.0f / DM) + RMS_EPS);
                float lg[8];
#pragma unroll
                for (int e = 0; e < 8; ++e) lg[e] = red[2368 + 9 * i + 1 + e] * rstd;
                int i0 = 0; float v0 = lg[0];
#pragma unroll
                for (int e = 1; e < 8; ++e) if (lg[e] > v0) { v0 = lg[e]; i0 = e; }
                int i1 = -1; float v1 = -3.0e38f;
#pragma unroll
                for (int e = 0; e < 8; ++e) if (e != i0 && lg[e] > v1) { v1 = lg[e]; i1 = e; }
                const float ex = __expf(v1 - v0), g0 = 1.0f / (1.0f + ex), g1 = ex * g0;
                rec[(tl0 + i) * 2] = i0; rec[(tl0 + i) * 2 + 1] = i1; GATES[2 * (t0 + i)] = g0; GATES[2 * (t0 + i) + 1] = g1; }
            asm volatile("s_waitcnt lgkmcnt(0)" ::: "memory");
        }
        __syncthreads();
        if (F.tid < 64) { const int tl = F.tid, e0 = rec[2 * tl], e1 = rec[2 * tl + 1]; int r0 = 0, r1 = 0;
            for (int k = 0; k < tl; ++k) { const int a = rec[2 * k], c = rec[2 * k + 1]; r0 += (a == e0) + (c == e0); r1 += (a == e1) + (c == e1); }
            ROUTE[tok64 + tl] = (unsigned)e0 | ((unsigned)e1 << 8) | ((unsigned)r0 << 16) | ((unsigned)r1 << 24);
        } else if (F.tid < 72) { const int e = F.tid - 64; int s = 0; for (int k = 0; k < 64; ++k) s += (rec[2 * k] == e) + (rec[2 * k + 1] == e); CNTWG[F.bid * 8 + e] = s; }
        __syncthreads();
    }
    SEAM(PH_ROUTE);

    if (IN(PH_SCAT)) {
        LAS int* tab = (LAS int*)(F.lds + RING_OFF);
        LAS int* tot = tab + 2048;
        for (int idx = F.tid; idx < 2048; idx += NTHREADS) tab[idx] = CNTWG[idx];
        const int tb = tok64 + F.wave * 8;
        unsigned rr[8]; v4u row[8]; float gts[16];
#pragma unroll
        for (int j = 0; j < 8; ++j) { rr[j] = ROUTE[tb + j]; row[j] = rowreg[j]; gts[2 * j] = GATES[2 * (tb + j)]; gts[2 * j + 1] = GATES[2 * (tb + j) + 1]; }
        __syncthreads();
        { const int e = F.wave; int s = 0, b = 0;
#pragma unroll
          for (int q = 0; q < 4; ++q) { const int wg = F.lane + 64 * q, c = tab[wg * 8 + e]; s += c; b += (wg < F.bid) ? c : 0; }
          s = wave_sum_i(s); b = wave_sum_i(b); if (F.lane == 0) { tot[e] = s; tot[8 + e] = b; } }
        __syncthreads();
        if (F.bid == 0 && F.tid == 0) { int tp = 0; META[0] = 0; for (int e = 0; e < 8; ++e) { tp += (tot[e] + 255) >> 8; META[e + 1] = tp; } }
        int ebase[8]; { int acc_ = 0;
#pragma unroll
          for (int q = 0; q < 8; ++q) { ebase[q] = acc_ + tot[8 + q]; acc_ += (tot[q] + 255) & ~255; } }
#pragma unroll
        for (int j = 0; j < 8; ++j) {
#pragma unroll
            for (int k = 0; k < 2; ++k) { const int e = (rr[j] >> (8 * k)) & 0xff, lr = (rr[j] >> (16 + 8 * k)) & 0xff; int eb = 0;
#pragma unroll
                for (int q = 0; q < 8; ++q) eb = (q == e) ? ebase[q] : eb;
                const int slot = eb + lr;
                ((GAS v4u*)(XS + (size_t)slot * DM))[F.lane] = row[j];
                if (F.lane == 0) { SDEST[slot] = 2 * (tb + j) + k; SGATE[slot] = gts[2 * j + k]; SLOTOF[2 * (tb + j) + k] = slot; } } }
        __syncthreads();
    }
    SEAM(PH_SCAT);

    if (lo <= PH_MOE + 1 && hi > PH_MOE) {
        if (F.tid < 9) ((LAS int*)(F.lds + MISC_OFF))[16 + F.tid] = META[F.tid];
        __syncthreads();
    }
    if (IN(PH_MOE)) {
        const LAS int* tp = (const LAS int*)(F.lds + MISC_OFF) + 16;
        pg8::Gemm g{(const bf16*)XS, (const bf16*)(ws + WS_WMGU), 0, 0, DM / 2, 0}; pg8::MoeOrder<28> S; S.init(tp[8], F.bid, tp);
        pg8::EpiSwigluF8 E{HIDM, FF, 1.0f / 16.0f};
        pg8::gemm_phase<pg8::EpiSwigluF8, pg8::MoeOrder<28>, true, true, true>(F.lds + RING_OFF, g, S, E);
    }
    SEAM(PH_MOE);
    if (IN(PH_MOE + 1)) {
        const LAS int* tp = (const LAS int*)(F.lds + MISC_OFF) + 16;
        { pg8::Gemm g{(const bf16*)HIDM, (const bf16*)(ws + WS_WMD), 0, 0, FF / 2, 0}; pg8::MoeOrder<4> S; S.init(tp[8] < 128 ? tp[8] : 128, F.bid, tp);
          LAS int* dtab = (LAS int*)(F.lds + MISC_OFF + 5120); LAS float* gtab = (LAS float*)(dtab + 512);
          { pg8::Unit uu;
#pragma unroll
            for (int i = 0; i < 2; ++i) if (S.next(i, uu) && F.tid < 256) { dtab[i * 256 + F.tid] = SDEST[uu.pm * 256 + F.tid]; gtab[i * 256 + F.tid] = SGATE[uu.pm * 256 + F.tid] * (1.0f / 32.0f); } }
          __syncthreads();
          pg8::EpiMoeDown E{PAIR, dtab, gtab, 0};
          pg8::gemm_phase<pg8::EpiMoeDown, pg8::MoeOrder<4>, true, true, true>(F.lds + RING_OFF, g, S, E); }
        { pg8::Gemm g{(const bf16*)HIDM, (const bf16*)(ws + WS_WMD), 0, 0, FF / 2, 4}; pg8::SplitKOrder S; S.init(tp[8], F.bid, tp);
          pg8::EpiPartF32 E{PART};
          pg8::gemm_phase<pg8::EpiPartF32, pg8::SplitKOrder, true, true, true>(F.lds + RING_OFF, g, S, E); }
    }
    SEAM(PH_MOE + 1);

    if (IN(PH_FINAL)) {
        for (int t = gw; t < SEQ; t += NGW) {
            GAS f32x4* xr = (GAS f32x4*)(H + (size_t)t * DM) + F.lane; const GAS f32x4* gr = (const GAS f32x4*)args.in[6] + F.lane;
            f32x4 v[4];
            { const GAS unsigned long long* hr = (const GAS unsigned long long*)(HN + (size_t)t * DM) + F.lane;
#pragma unroll
              for (int q = 0; q < 4; ++q) { const unsigned long long a = __builtin_nontemporal_load(hr + 64 * q);
                  v[q] = (f32x4){bf2f((unsigned short)a), bf2f((unsigned short)(a >> 16)), bf2f((unsigned short)(a >> 32)), bf2f((unsigned short)(a >> 48))}; } }
#pragma unroll
            for (int k = 0; k < 2; ++k) { const int slot = SLOTOF[2 * t + k];
                if ((slot >> 8) < 128) { const GAS unsigned long long* pa = (const GAS unsigned long long*)(PAIR + (size_t)(2 * t + k) * DM) + F.lane;
#pragma unroll
                    for (int q = 0; q < 4; ++q) { const unsigned long long a = __builtin_nontemporal_load(pa + 64 * q);
                        v[q].x += bf2f((unsigned short)a); v[q].y += bf2f((unsigned short)(a >> 16)); v[q].z += bf2f((unsigned short)(a >> 32)); v[q].w += bf2f((unsigned short)(a >> 48)); }
                } else { const int lt = (slot >> 8) - 128, rl = slot & 255; const float gt = GATES[2 * t + k] * (1.0f / 32.0f);
#pragma unroll
                    for (int q = 0; q < 4; ++q) { const GAS f32x4* pp = (const GAS f32x4*)(PART + (size_t)((lt * 4 + q) * 7) * 65536 + rl * 256) + F.lane; f32x4 s = pp[0];
#pragma unroll
                        for (int sl = 1; sl < 7; ++sl) s += pp[(size_t)sl * 16384];
                        v[q] += s * gt; } } }
            float s = 0.f;
#pragma unroll
            for (int q = 0; q < 4; ++q) s += (v[q].x * v[q].x + v[q].y * v[q].y) + (v[q].z * v[q].z + v[q].w * v[q].w);
            const float rstd = 1.0f / sqrtf(wave_sum(s) * (1.0f / DM) + RMS_EPS);
#pragma unroll
            for (int q = 0; q < 4; ++q) __builtin_nontemporal_store(v[q] * rstd * gr[64 * q], xr + 64 * q);
        }
    }
#undef IN
#undef SEAM
#undef ws
}

extern "C" void kernel_launch(void* const* d_in, const int* in_sizes, int n_in, void* d_out, int out_size, void* d_ws, size_t ws_size, hipStream_t stream) {
    static int ready = 0;
    if (ready == 0) {
        if (n_in != 21 || in_sizes[0] != SEQ * DM || out_size != SEQ * DM || ws_size < WS_END) { fprintf(stderr, "kernel_launch: unexpected shapes (n_in %d, in0 %d, out %d, ws %zu); nothing launched\n", n_in, n_in > 0 ? in_sizes[0] : -1, out_size, ws_size); ready = -1; return; }
        if (hipFuncSetAttribute((const void*)fwd, hipFuncAttributeMaxDynamicSharedMemorySize, LDS_BYTES) != hipSuccess) { fprintf(stderr, "kernel_launch: hipFuncSetAttribute failed\n"); ready = -1; return; }
        int per_cu = 0;
        if (hipOccupancyMaxActiveBlocksPerMultiprocessor(&per_cu, (const void*)fwd, NTHREADS, LDS_BYTES) != hipSuccess || per_cu < 1) fprintf(stderr, "kernel_launch: occupancy query reports %d workgroups per CU\n", per_cu);
        (void)hipGetLastError();
        ready = 1;
    }
    if (ready < 0) return;
    if (hipMemsetAsync((char*)d_ws + WS_CTL, 0, CTL_ZERO_BYTES, stream) != hipSuccess) { fprintf(stderr, "kernel_launch: memset failed\n"); return; }
    Args a{};
    for (int i = 0; i < 21; ++i) a.in[i] = (const float*)d_in[i];
    a.out = (float*)d_out; a.ws = (unsigned char*)d_ws;
#if MK_PER_PHASE
    for (int p = 0; p < N_PHASES; ++p) { a.ph_lo = p; a.ph_hi = p + 1; hipLaunchKernelGGL(fwd, dim3(GRID), dim3(NTHREADS), LDS_BYTES, stream, a); }
#else
    a.ph_lo = 0; a.ph_hi = N_PHASES;
    hipLaunchKernelGGL(fwd, dim3(GRID), dim3(NTHREADS), LDS_BYTES, stream, a);
#ifdef PROBE_LIST
    { static const int probe_[] = {PROBE_LIST};
      for (unsigned i = 0; i < sizeof(probe_) / sizeof(int); ++i) { a.ph_lo = probe_[i]; a.ph_hi = probe_[i] + 1; hipLaunchKernelGGL(fwd, dim3(GRID), dim3(NTHREADS), LDS_BYTES, stream, a); } }
#endif
#endif
    const hipError_t le = hipPeekAtLastError();
    if (le != hipSuccess) fprintf(stderr, "kernel_launch: launch failed: %s\n", hipGetErrorName(le));
}
```

```cpp
#include <hip/hip_runtime.h>
#include <cstdio>
#include <cstdint>
#include <cmath>
namespace pg8 {
#define PG8_LAS __attribute__((address_space(3)))
typedef unsigned short bf16_t;
typedef short bf16x8 __attribute__((ext_vector_type(8)));
typedef float f32x4 __attribute__((ext_vector_type(4)));
typedef unsigned u32x4 __attribute__((ext_vector_type(4)));
constexpr int BM = 256, BK = 64, HALF = 128, HTB = HALF * BK * 2  , STAGE_BYTES = 8 * HTB, NXCD = 8, WGM = 8;

__host__ __device__ __forceinline__ int lds_byte(int r, int c) { const int st = (r >> 4) * 2 + (c >> 5), rr = r & 15, cc = c & 31, ob = rr * 64 + cc * 2; return st * 1024 + (ob ^ (((ob >> 9) & 1) << 5)); }
__host__ __device__ __forceinline__ void stage_rc(int b, int& R, int& C) { const int st = b / 1024, sb = b % 1024, swz = sb ^ (((sb >> 9) & 1) << 5); R = (st >> 1) * 16 + swz / 64; C = (st & 1) * 32 + (swz % 64) / 2; }
__host__ __device__ __forceinline__ int perm32(int rho) { const int n = rho >> 4, i = rho & 15; return 8 * (i >> 2) + 4 * n + (i & 3); }

struct Unit { int pm, pn, ko; };
struct Gemm { const bf16_t* A; const bf16_t* Bt; int M, N, K; int nt; };

struct StaticOrder {
    int nM, nN, nwg, G, c;
    __host__ __device__ __forceinline__ void init(int M, int N, int G_, int c_) { nM = M / BM; nN = N / BM; nwg = nM * nN; G = G_; c = c_; }
    __host__ __device__ __forceinline__ bool next(int i, Unit& u) const {
        const long L = (long)i * G + c; if (L >= nwg) return false;
        int wgid = (int)L; { const int q = nwg / NXCD, r = nwg % NXCD, xcd = wgid % NXCD, off = wgid / NXCD; wgid = (xcd < r ? xcd * (q + 1) : r * (q + 1) + (xcd - r) * q) + off; }
        const int nig = WGM * nN, gid = wgid / nig, fm = gid * WGM, gsz = (nM - fm) < WGM ? (nM - fm) : WGM;
        u.pm = fm + ((wgid % nig) % gsz); u.pn = (wgid % nig) / gsz; u.ko = 0; return true;
    }
    __device__ __forceinline__ void a_ready(const Unit&) const {}
    __device__ __forceinline__ void done(const Unit&) const {}
};

typedef float f32x2 __attribute__((ext_vector_type(2)));
typedef __bf16 bf16x2_t __attribute__((ext_vector_type(2)));
__device__ __forceinline__ unsigned cvt_pk_bf16(float lo, float hi) { const f32x2 v = {lo, hi}; const bf16x2_t b = __builtin_convertvector(v, bf16x2_t); return __builtin_bit_cast(unsigned, b); }

typedef unsigned u32x2 __attribute__((ext_vector_type(2)));
struct EpiPlainBf16 {
    static constexpr bool PERM = true, AFTER_DRAIN = false, INIT_ACC = false;
    bf16_t* O; int ldc; unsigned smask; float sval; const PG8_LAS float* rt;
    __device__ __forceinline__ void operator()(const f32x4 (&acc)[2][2][4][2], const Unit& u, int wr, int wc, int fr, int fq) const {
        const int row0 = u.pm * BM + wr * 64 + fr, col0 = u.pn * BM + wc * 32 + 8 * fq;
        const float sc0 = ((smask >> (2 * u.pn)) & 1u) ? sval : 1.0f, sc1 = ((smask >> (2 * u.pn + 1)) & 1u) ? sval : 1.0f;
#pragma unroll
        for (int ai = 0; ai < 2; ++ai)
#pragma unroll
            for (int m = 0; m < 4; ++m) { bf16_t* rowp = O + (size_t)(row0 + ai * HALF + m * 16) * ldc + col0;
                const float rs = rt ? rt[ai * HALF + wr * 64 + m * 16 + fr] : 1.0f;
#pragma unroll
                for (int bj = 0; bj < 2; ++bj) { const float sc = (bj ? sc1 : sc0) * rs; const f32x4 v0 = acc[ai][bj][m][0] * sc, v1 = acc[ai][bj][m][1] * sc;
                    u32x4 w; w.x = cvt_pk_bf16(v0[0], v0[1]); w.y = cvt_pk_bf16(v0[2], v0[3]); w.z = cvt_pk_bf16(v1[0], v1[1]); w.w = cvt_pk_bf16(v1[2], v1[3]);
                    *(u32x4*)(rowp + bj * HALF) = w; } }
    }
};
__device__ __forceinline__ float row_rstd(const float* ss, int row) { const f32x4 p = *(const f32x4*)(ss + (size_t)row * 4); return 1.0f / sqrtf(((p[0] + p[1]) + (p[2] + p[3])) * (1.0f / 1024.0f) + 1e-5f); }
struct EpiResF32 {
    static constexpr bool PERM = true, AFTER_DRAIN = false, INIT_ACC = true;
    const float* base; const bf16_t* bbase; float* out; int ldc; bf16_t* hb; float* ss; int lp_off;
    __device__ __forceinline__ void init(f32x4 (&acc)[2][2][4][2], const Unit& u, int wr, int wc, int fr, int fq) const {
        const int col0 = u.pn * BM + wc * 32 + 8 * fq;
#pragma unroll
        for (int ai = 0; ai < 2; ++ai)
#pragma unroll
            for (int m = 0; m < 4; ++m) { const size_t off = (size_t)(u.pm * BM + ai * HALF + wr * 64 + m * 16 + fr) * ldc + col0;
#pragma unroll
                for (int bj = 0; bj < 2; ++bj) {
                    if (base) {
#pragma unroll
                        for (int n = 0; n < 2; ++n) acc[ai][bj][m][n] = *(const f32x4*)(base + off + bj * HALF + 4 * n);
                    } else { const u32x4 w = *(const u32x4*)(bbase + off + bj * HALF);
                        acc[ai][bj][m][0] = (f32x4){__builtin_bit_cast(float, w.x << 16), __builtin_bit_cast(float, w.x & 0xffff0000u), __builtin_bit_cast(float, w.y << 16), __builtin_bit_cast(float, w.y & 0xffff0000u)};
                        acc[ai][bj][m][1] = (f32x4){__builtin_bit_cast(float, w.z << 16), __builtin_bit_cast(float, w.z & 0xffff0000u), __builtin_bit_cast(float, w.w << 16), __builtin_bit_cast(float, w.w & 0xffff0000u)}; } } }
    }
    __device__ __forceinline__ void operator()(const f32x4 (&acc)[2][2][4][2], const Unit& u, int wr, int wc, int fr, int fq) const {
        const int col0 = u.pn * BM + wc * 32 + 8 * fq; PG8_LAS float* lp = (PG8_LAS float*)(size_t)lp_off;
#pragma unroll
        for (int ai = 0; ai < 2; ++ai)
#pragma unroll
            for (int m = 0; m < 4; ++m) { const int rl = ai * HALF + wr * 64 + m * 16 + fr; const size_t off = (size_t)(u.pm * BM + rl) * ldc + col0; float s = 0.f;
#pragma unroll
                for (int bj = 0; bj < 2; ++bj) { const f32x4 v0 = acc[ai][bj][m][0], v1 = acc[ai][bj][m][1];
                    if (out) { *(f32x4*)(out + off + bj * HALF) = v0; *(f32x4*)(out + off + bj * HALF + 4) = v1; }
                    if (hb) { if (ss) s += ((v0[0] * v0[0] + v0[1] * v0[1]) + (v0[2] * v0[2] + v0[3] * v0[3])) + ((v1[0] * v1[0] + v1[1] * v1[1]) + (v1[2] * v1[2] + v1[3] * v1[3]));
                        u32x4 w; w.x = cvt_pk_bf16(v0[0], v0[1]); w.y = cvt_pk_bf16(v0[2], v0[3]); w.z = cvt_pk_bf16(v1[0], v1[1]); w.w = cvt_pk_bf16(v1[2], v1[3]); *(u32x4*)(hb + off + bj * HALF) = w; } }
                if (ss) { s += __shfl_xor(s, 16); s += __shfl_xor(s, 32); if (fq == 0) lp[rl * 4 + wc] = s; } }
        if (ss) { asm volatile("s_waitcnt lgkmcnt(0)" ::: "memory"); __builtin_amdgcn_s_barrier(); asm volatile("" ::: "memory");
            const int tid = threadIdx.x;
            if (tid < 256) { const f32x4 p = *(const PG8_LAS f32x4*)(lp + tid * 4); ss[(size_t)(u.pm * BM + tid) * 4 + u.pn] = (p[0] + p[1]) + (p[2] + p[3]); } }
    }
};
__device__ __forceinline__ float silu_mul(float g, float u) { return g * __builtin_amdgcn_rcpf(1.0f + __builtin_amdgcn_exp2f(g * -1.4426950408889634f)) * u; }
__device__ __forceinline__ f32x2 silu_mul2(f32x2 g, f32x2 u, float c1, float k) {
    const f32x2 a = g * c1; f32x2 e; e[0] = __builtin_amdgcn_exp2f(a[0]); e[1] = __builtin_amdgcn_exp2f(a[1]);
    const f32x2 kk = {k, k}; const f32x2 d = __builtin_elementwise_fma(e, kk, kk); f32x2 r; r[0] = __builtin_amdgcn_rcpf(d[0]); r[1] = __builtin_amdgcn_rcpf(d[1]);
    return (g * u) * r;
}
struct EpiSwiglu {
    static constexpr bool PERM = true, AFTER_DRAIN = false, INIT_ACC = false;
    bf16_t* O; int ldc; int pn_mod; const PG8_LAS float* rt;
    __device__ __forceinline__ void operator()(const f32x4 (&acc)[2][2][4][2], const Unit& u, int wr, int wc, int fr, int fq) const {
        const int row0 = u.pm * BM + wr * 64 + fr, col0 = (u.pn % pn_mod) * HALF + wc * 32 + 8 * fq;
#pragma unroll
        for (int ai = 0; ai < 2; ++ai)
#pragma unroll
            for (int m = 0; m < 4; ++m) { bf16_t* rowp = O + (size_t)(row0 + ai * HALF + m * 16) * ldc + col0;
                const float rs = rt ? rt[ai * HALF + wr * 64 + m * 16 + fr] : 1.0f, c1 = rs * -1.4426950408889634f, k = __builtin_amdgcn_rcpf(rs * rs);
                const f32x4 g0 = acc[ai][0][m][0], g1 = acc[ai][0][m][1], u0 = acc[ai][1][m][0], u1 = acc[ai][1][m][1];
                const f32x2 o0 = silu_mul2(g0.xy, u0.xy, c1, k), o1 = silu_mul2(g0.zw, u0.zw, c1, k), o2 = silu_mul2(g1.xy, u1.xy, c1, k), o3 = silu_mul2(g1.zw, u1.zw, c1, k);
                u32x4 w; w.x = cvt_pk_bf16(o0[0], o0[1]); w.y = cvt_pk_bf16(o1[0], o1[1]); w.z = cvt_pk_bf16(o2[0], o2[1]); w.w = cvt_pk_bf16(o3[0], o3[1]);
                *(u32x4*)rowp = w; }
    }
};
struct EpiMoeDown {
    static constexpr bool PERM = true, AFTER_DRAIN = false, INIT_ACC = false;
    bf16_t* O; const PG8_LAS int* dtab; const PG8_LAS float* gtab; mutable int ui;
    __device__ __forceinline__ void operator()(const f32x4 (&acc)[2][2][4][2], const Unit& u, int wr, int wc, int fr, int fq) const {
        const int rl0 = ui * BM + wr * 64 + fr, col0 = (u.pn & 3) * BM + wc * 32 + 8 * fq;
#pragma unroll
        for (int ai = 0; ai < 2; ++ai)
#pragma unroll
            for (int m = 0; m < 4; ++m) { const int rl = rl0 + ai * HALF + m * 16; const int d = dtab[rl];
                if (d >= 0) { const float gt = gtab[rl]; bf16_t* rowp = O + (size_t)d * 1024 + col0;
#pragma unroll
                    for (int bj = 0; bj < 2; ++bj) { const f32x4 v0 = acc[ai][bj][m][0] * gt, v1 = acc[ai][bj][m][1] * gt;
                        u32x4 w; w.x = cvt_pk_bf16(v0[0], v0[1]); w.y = cvt_pk_bf16(v0[2], v0[3]); w.z = cvt_pk_bf16(v1[0], v1[1]); w.w = cvt_pk_bf16(v1[2], v1[3]);
                        *(u32x4*)(rowp + bj * HALF) = w; } } }
        ++ui;
    }
};
typedef int i32x8 __attribute__((ext_vector_type(8)));
typedef int i32x4v __attribute__((ext_vector_type(4)));
__device__ __forceinline__ i32x8 cat8(bf16x8 lo, bf16x8 hi) { const i32x4v a = __builtin_bit_cast(i32x4v, lo), b = __builtin_bit_cast(i32x4v, hi); return __builtin_shufflevector(a, b, 0, 1, 2, 3, 4, 5, 6, 7); }
__device__ __forceinline__ unsigned pk4_fp8(float a, float b, float c, float d) { int w = 0; w = __builtin_amdgcn_cvt_pk_fp8_f32(a, b, w, false); w = __builtin_amdgcn_cvt_pk_fp8_f32(c, d, w, true); return (unsigned)w; }
struct EpiSwigluF8 {
    static constexpr bool PERM = true, AFTER_DRAIN = false, INIT_ACC = false;
    unsigned char* O; int ldc; float sc;
    __device__ __forceinline__ void operator()(const f32x4 (&acc)[2][2][4][2], const Unit& u, int wr, int wc, int fr, int fq) const {
        const int row0 = u.pm * BM + wr * 64 + fr, col0 = (u.pn % 28) * HALF + wc * 32 + 8 * fq;
#pragma unroll
        for (int ai = 0; ai < 2; ++ai)
#pragma unroll
            for (int m = 0; m < 4; ++m) { unsigned char* rowp = O + (size_t)(row0 + ai * HALF + m * 16) * ldc + col0;
                const float c1 = sc * -1.4426950408889634f, k = 1.0f / (sc * sc);
                const f32x4 g0 = acc[ai][0][m][0], g1 = acc[ai][0][m][1], u0 = acc[ai][1][m][0], u1 = acc[ai][1][m][1];
                const f32x2 o0 = silu_mul2(g0.xy, u0.xy, c1, k), o1 = silu_mul2(g0.zw, u0.zw, c1, k), o2 = silu_mul2(g1.xy, u1.xy, c1, k), o3 = silu_mul2(g1.zw, u1.zw, c1, k);
                u32x2 w; w.x = pk4_fp8(o0[0], o0[1], o1[0], o1[1]); w.y = pk4_fp8(o2[0], o2[1], o3[0], o3[1]);
                *(u32x2*)rowp = w; }
    }
};
template <int NN> struct MoeOrder {
    int nx, nq, x, j; unsigned recip; const PG8_LAS int* tp;
    __device__ __forceinline__ void init(int T, int c, const PG8_LAS int* tp_) { x = c & 7; j = c >> 3; nx = (T - x + 7) >> 3; if (nx < 0) nx = 0; nq = nx * NN; tp = tp_;
        recip = nx > 0 ? (unsigned)(__builtin_amdgcn_rcpf((float)nx) * 1048576.0f) + 1u : 0u; }
    __device__ __forceinline__ bool next(int i, Unit& u) const {
        const int q = i * 32 + j; if (q >= nq) return false;
        int pn, pm;
        if (NN == 4) { pn = q & 3; pm = 8 * (q >> 2) + x; }
        else { pn = (int)(((unsigned)q * recip) >> 20); pm = 8 * (q - pn * nx) + x; }
        int e = 0;
#pragma unroll
        for (int k = 1; k < 8; ++k) e += (pm >= tp[k]) ? 1 : 0;
        u.pm = pm; u.pn = e * NN + pn; u.ko = 0; return true;
    }
    __device__ __forceinline__ void a_ready(const Unit&) const {}
    __device__ __forceinline__ void done(const Unit&) const {}
};
struct SplitKOrder {
    int nsub, c; const PG8_LAS int* tp;
    __device__ __forceinline__ void init(int T, int c_, const PG8_LAS int* tp_) { nsub = T > 128 ? (T - 128) * 28 : 0; c = c_; tp = tp_; }
    __device__ __forceinline__ bool next(int i, Unit& u) const {
        if (i != 0 || c >= nsub) return false;
        const int lt = c / 28, rem = c - lt * 28, pn = rem / 7, s = rem - pn * 7, pm = 128 + lt; int e = 0;
#pragma unroll
        for (int k = 1; k < 8; ++k) e += (pm >= tp[k]) ? 1 : 0;
        u.pm = pm; u.pn = e * 4 + pn; u.ko = s * 512; return true;
    }
    __device__ __forceinline__ void a_ready(const Unit&) const {}
    __device__ __forceinline__ void done(const Unit&) const {}
};
struct EpiPartF32 {
    static constexpr bool PERM = false, AFTER_DRAIN = false, INIT_ACC = false;
    float* part;
    __device__ __forceinline__ void operator()(const f32x4 (&acc)[2][2][4][2], const Unit& u, int wr, int wc, int fr, int fq) const {
        float* tile = part + (size_t)(((u.pm - 128) * 4 + (u.pn & 3)) * 7 + u.ko / 512) * 65536 + wc * 32 + 4 * fq;
#pragma unroll
        for (int ai = 0; ai < 2; ++ai)
#pragma unroll
            for (int m = 0; m < 4; ++m) { float* rowp = tile + (ai * HALF + wr * 64 + m * 16 + fr) * 256;
#pragma unroll
                for (int bj = 0; bj < 2; ++bj)
#pragma unroll
                    for (int n = 0; n < 2; ++n) *(f32x4*)(rowp + bj * HALF + n * 16) = acc[ai][bj][m][n]; }
    }
};

template <bool F8> struct Frag;
template <> struct Frag<false> { struct A { bf16x8 k[2]; };
    static __device__ __forceinline__ void load(A& d, const PG8_LAS unsigned char* p) { d.k[0] = *(const PG8_LAS bf16x8*)p; d.k[1] = *(const PG8_LAS bf16x8*)(p + 1024); }
    static __device__ __forceinline__ void mma(f32x4& acc, const A& b, const A& a) { acc = __builtin_amdgcn_mfma_f32_16x16x32_bf16(b.k[0], a.k[0], acc, 0, 0, 0); acc = __builtin_amdgcn_mfma_f32_16x16x32_bf16(b.k[1], a.k[1], acc, 0, 0, 0); } };
template <> struct Frag<true> { typedef i32x8 A;
    static __device__ __forceinline__ void load(A& d, const PG8_LAS unsigned char* p) { const i32x4v lo = *(const PG8_LAS i32x4v*)p, hi = *(const PG8_LAS i32x4v*)(p + 1024); d = __builtin_shufflevector(lo, hi, 0, 1, 2, 3, 4, 5, 6, 7); }
    static __device__ __forceinline__ void mma(f32x4& acc, const A& b, const A& a) {
        asm volatile("v_mfma_scale_f32_16x16x128_f8f6f4 %0, %1, %2, %0, %3, %3 op_sel_hi:[0,0,0]" : "+v"(acc) : "v"(b), "v"(a), "v"(0x7f7f7f7f)); } };
template <class Epi, class Sched, bool ALIGN_EPI = false, bool SP2 = false, bool F8 = false>
__device__ __forceinline__ void gemm_phase(PG8_LAS unsigned char* lds, const Gemm g, const Sched& S, const Epi& E) {
    int tid_ = threadIdx.x; asm volatile("" : "+v"(tid_));
    const int tid = tid_, wid = __builtin_amdgcn_readfirstlane(tid >> 6), lane = tid & 63, wr = wid >> 2, wc = wid & 3, fr = lane & 15, fq = lane >> 4;
    const int K = g.K, nt = g.nt ? g.nt : K / BK;
    unsigned voffA[2], voffB[2];
#pragma unroll
    for (int i = 0; i < 2; ++i) { int R, C; stage_rc(tid * 16 + i * 8192, R, C); const int Rb = Epi::PERM ? ((R & ~31) + perm32(R & 31)) : R;
        voffA[i] = (unsigned)(R * K + C) * 2u; voffB[i] = (unsigned)(Rb * K + C) * 2u; }
    const size_t kstep = (size_t)(BK * 2);
    const size_t hstep = (size_t)HALF * K * 2;
    const size_t tstep = 2 * hstep;
    const unsigned ldsw = (unsigned)wid * 1024u;
    const int aoff = lds_byte(wr * 64 + fr, fq * 8), boff = lds_byte(wc * 32 + fr, fq * 8);
#define PG8_SA(b, h) (((b) * 2 + (h)) * HTB)
#define PG8_SB(b, h) ((4 + (b) * 2 + (h)) * HTB)
#define PG8_STAGE(bufoff, gbase, voff) do { _Pragma("unroll") for (int _i = 0; _i < 2; ++_i) \
        __builtin_amdgcn_global_load_lds((const unsigned*)((const char*)(gbase) + (voff)[_i]), (PG8_LAS unsigned*)(lds + (bufoff) + ldsw + _i * 8192), 16, 0, 0); } while (0)
#define PG8_LDA(dst, b, h) do { _Pragma("unroll") for (int m = 0; m < 4; ++m) Frag<F8>::load(dst[m], lds + PG8_SA(b, h) + aoff + m * 2048); } while (0)
#define PG8_LDB(dst, b, h) do { _Pragma("unroll") for (int n = 0; n < 2; ++n) Frag<F8>::load(dst[n], lds + PG8_SB(b, h) + boff + n * 2048); } while (0)
#define PG8_MMA(ai, bj, At, Bt) do { __builtin_amdgcn_s_setprio(1); _Pragma("unroll") for (int m = 0; m < 4; ++m) _Pragma("unroll") for (int n = 0; n < 2; ++n) Frag<F8>::mma(acc[ai][bj][m][n], Bt[n], At[m]); \
        __builtin_amdgcn_s_setprio(0); } while (0)
#define PG8_WAIT_V(n) asm volatile("s_waitcnt vmcnt(" #n ")" ::: "memory")
#define PG8_WAIT_L(n) asm volatile("s_waitcnt lgkmcnt(" #n ")" ::: "memory")
#define PG8_BAR __builtin_amdgcn_s_barrier()
#define PG8_SCHED __builtin_amdgcn_sched_barrier(0)
    Unit cur, nxt; int ui = 0;
    if (!S.next(0, cur)) return;
    f32x4 acc[2][2][4][2];
    if constexpr (Epi::INIT_ACC) E.init(acc, cur, wr, wc, fr, fq);
    else {
#pragma unroll
    for (int a = 0; a < 2; ++a)
#pragma unroll
        for (int b = 0; b < 2; ++b)
#pragma unroll
            for (int m = 0; m < 4; ++m)
#pragma unroll
                for (int n = 0; n < 2; ++n) acc[a][b][m][n] = (f32x4){0.f, 0.f, 0.f, 0.f};
    }
    typename Frag<F8>::A At[4]; typename Frag<F8>::A B0[2], B1[2];
    const char* cA = (const char*)g.A + (size_t)cur.pm * tstep + cur.ko; const char* cB = (const char*)g.Bt + (size_t)cur.pn * tstep + cur.ko;
    S.a_ready(cur);
    if constexpr (SP2) {
        PG8_STAGE(PG8_SB(0, 0), cB, voffB); PG8_STAGE(PG8_SB(0, 1), cB + hstep, voffB); PG8_STAGE(PG8_SA(0, 0), cA, voffA); PG8_STAGE(PG8_SA(0, 1), cA + hstep, voffA);
        if (wr == 1) PG8_BAR;
        PG8_WAIT_V(2); PG8_BAR;
        PG8_STAGE(PG8_SB(1, 0), cB + kstep, voffB); PG8_STAGE(PG8_SA(1, 0), cA + kstep, voffA); PG8_STAGE(PG8_SB(1, 1), cB + hstep + kstep, voffB);
        PG8_WAIT_V(6); PG8_BAR;
    } else {
        PG8_STAGE(PG8_SB(0, 0), cB, voffB); PG8_STAGE(PG8_SA(0, 0), cA, voffA); PG8_STAGE(PG8_SB(0, 1), cB + hstep, voffB); PG8_STAGE(PG8_SA(0, 1), cA + hstep, voffA);
        if (wr == 1) PG8_BAR;
        PG8_WAIT_V(4); PG8_BAR;
        PG8_STAGE(PG8_SB(1, 0), cB + kstep, voffB); PG8_STAGE(PG8_SA(1, 0), cA + kstep, voffA); PG8_STAGE(PG8_SB(1, 1), cB + hstep + kstep, voffB);
        PG8_WAIT_V(6); PG8_BAR;
    }
    for (;;) {
        const bool has_next = S.next(ui + 1, nxt);
        const char* nA = has_next ? (const char*)g.A + (size_t)nxt.pm * tstep + nxt.ko : cA; const char* nB = has_next ? (const char*)g.Bt + (size_t)nxt.pn * tstep + nxt.ko : cB;
        for (int t = 0; t < nt; t += 2) {
            const bool last = (t == nt - 2);
            const char* a1 = cA + (size_t)(t + 1) * kstep;
            const char* a2 = last ? nA : cA + (size_t)(t + 2) * kstep; const char* b2 = last ? nB : cB + (size_t)(t + 2) * kstep;
            const char* a3 = a2 + kstep; const char* b3 = b2 + kstep;
            if (last && has_next) S.a_ready(nxt);
            if constexpr (SP2) {
            PG8_LDB(B0, 0, 0); PG8_LDB(B1, 0, 1); PG8_SCHED; PG8_LDA(At, 0, 0); PG8_STAGE(PG8_SA(1, 1), a1 + hstep, voffA);
            PG8_WAIT_V(8); PG8_WAIT_L(0); PG8_BAR; PG8_MMA(0, 0, At, B0); PG8_MMA(0, 1, At, B1); PG8_BAR; PG8_SCHED;
            PG8_LDA(At, 0, 1); PG8_STAGE(PG8_SB(0, 0), b2, voffB); PG8_STAGE(PG8_SB(0, 1), b2 + hstep, voffB); PG8_STAGE(PG8_SA(0, 0), a2, voffA);
            PG8_WAIT_V(8); PG8_WAIT_L(0); PG8_BAR; PG8_MMA(1, 0, At, B0); PG8_MMA(1, 1, At, B1); PG8_BAR; PG8_SCHED;
            PG8_LDB(B0, 1, 0); PG8_LDB(B1, 1, 1); PG8_SCHED; PG8_LDA(At, 1, 0); PG8_STAGE(PG8_SA(0, 1), a2 + hstep, voffA);
            PG8_WAIT_V(8); PG8_WAIT_L(0); PG8_BAR; PG8_MMA(0, 0, At, B0); PG8_MMA(0, 1, At, B1); PG8_BAR; PG8_SCHED;
            PG8_LDA(At, 1, 1); PG8_STAGE(PG8_SB(1, 0), b3, voffB); PG8_STAGE(PG8_SB(1, 1), b3 + hstep, voffB); PG8_STAGE(PG8_SA(1, 0), a3, voffA);
            PG8_WAIT_V(8); PG8_WAIT_L(0); PG8_BAR; PG8_MMA(1, 0, At, B0); PG8_MMA(1, 1, At, B1); PG8_BAR; PG8_SCHED;
            } else {
            PG8_LDB(B0, 0, 0); PG8_SCHED; PG8_LDA(At, 0, 0); PG8_STAGE(PG8_SA(1, 1), a1 + hstep, voffA);
            PG8_WAIT_L(8); PG8_BAR; PG8_WAIT_L(0); PG8_MMA(0, 0, At, B0); PG8_BAR; PG8_SCHED;
            PG8_LDB(B1, 0, 1); PG8_STAGE(PG8_SB(0, 0), b2, voffB);
            PG8_BAR; PG8_WAIT_L(0); PG8_MMA(0, 1, At, B1); PG8_BAR;
            PG8_LDA(At, 0, 1); PG8_STAGE(PG8_SA(0, 0), a2, voffA);
            PG8_BAR; PG8_WAIT_L(0); PG8_MMA(1, 0, At, B0); PG8_BAR; PG8_SCHED;
            PG8_STAGE(PG8_SB(0, 1), b2 + hstep, voffB);
            PG8_WAIT_V(6); PG8_BAR; PG8_MMA(1, 1, At, B1); PG8_BAR;
            PG8_LDB(B0, 1, 0); PG8_SCHED; PG8_LDA(At, 1, 0); PG8_STAGE(PG8_SA(0, 1), a2 + hstep, voffA);
            PG8_WAIT_L(8); PG8_BAR; PG8_WAIT_L(0); PG8_MMA(0, 0, At, B0); PG8_BAR; PG8_SCHED;
            PG8_LDB(B1, 1, 1); PG8_STAGE(PG8_SB(1, 0), b3, voffB);
            PG8_BAR; PG8_WAIT_L(0); PG8_MMA(0, 1, At, B1); PG8_BAR;
            PG8_LDA(At, 1, 1); PG8_STAGE(PG8_SA(1, 0), a3, voffA);
            PG8_BAR; PG8_WAIT_L(0); PG8_MMA(1, 0, At, B0); PG8_BAR; PG8_SCHED;
            PG8_STAGE(PG8_SB(1, 1), b3 + hstep, voffB);
            PG8_WAIT_V(6); PG8_BAR; PG8_MMA(1, 1, At, B1); PG8_BAR;
            }
        }
        if constexpr (ALIGN_EPI) { if (wr == 0) PG8_BAR; }
        if constexpr (F8) { asm volatile("s_nop 15\n\ts_nop 15" ::: "memory"); PG8_SCHED; }
        if constexpr (!Epi::AFTER_DRAIN) { E(acc, cur, wr, wc, fr, fq); S.done(cur); }
        if (!has_next) break;
#pragma unroll
        for (int a = 0; a < 2; ++a)
#pragma unroll
            for (int b = 0; b < 2; ++b)
#pragma unroll
                for (int m = 0; m < 4; ++m)
#pragma unroll
                    for (int n = 0; n < 2; ++n) acc[a][b][m][n] = (f32x4){0.f, 0.f, 0.f, 0.f};
        cur = nxt; cA = nA; cB = nB; ++ui;
        if constexpr (ALIGN_EPI) { if (wr == 1) PG8_BAR; }
    }
    PG8_WAIT_V(0);
    if constexpr (!ALIGN_EPI) { if (wr == 0) PG8_BAR; }
    PG8_BAR;
    if constexpr (Epi::AFTER_DRAIN) { E.fused(acc, cur, wr, wc, fr, fq, lds, wid, lane); S.done(cur); }
#undef PG8_SA
#undef PG8_SB
#undef PG8_STAGE
#undef PG8_LDA
#undef PG8_LDB
#undef PG8_MMA
#undef PG8_WAIT_V
#undef PG8_WAIT_L
#undef PG8_BAR
#undef PG8_SCHED
}
}

#define GAS __attribute__((address_space(1)))
#define LAS __attribute__((address_space(3)))
typedef unsigned short bf16;
typedef unsigned v4u __attribute__((ext_vector_type(4)));
typedef float f32x4 __attribute__((ext_vector_type(4)));
typedef short bf16x8 __attribute__((ext_vector_type(8)));
typedef GAS unsigned gu32;
typedef GAS unsigned long long gu64;
#define RLX_AGENT __ATOMIC_RELAXED, __HIP_MEMORY_SCOPE_AGENT
#define LDS_WAIT() asm volatile("s_waitcnt lgkmcnt(0)" ::: "memory")
#define VM_WAIT() asm volatile("s_waitcnt vmcnt(0)" ::: "memory")
__device__ __forceinline__ unsigned long long rt() { return __builtin_amdgcn_s_memrealtime(); }
__device__ __forceinline__ unsigned f2bf(float f) { unsigned u = __builtin_bit_cast(unsigned, f); return (u + 0x7fffu + ((u >> 16) & 1u)) >> 16; }
__device__ __forceinline__ unsigned pk2(float lo, float hi) { return f2bf(lo) | (f2bf(hi) << 16); }

#define XB_TMO      128
#define XB_XCNT(j)  (256  + 64 * (j))
#define XB_XSUB(j)  (1280 + 64 * (j))
#define XB_XGEN(j)  (2304 + 64 * (j))
#define XB_TOP      3328
#define XB_TOPGEN   3392
#define XCD_BAR_WORDS 3456
#define XB_SPIN_CAP (1u << 18)

__device__ __forceinline__ unsigned xb_ld(unsigned* p)              { return __hip_atomic_load(p, __ATOMIC_RELAXED, __HIP_MEMORY_SCOPE_AGENT); }
__device__ __forceinline__ unsigned xb_add(unsigned* p, unsigned v) { return __hip_atomic_fetch_add(p, v, __ATOMIC_RELAXED, __HIP_MEMORY_SCOPE_AGENT); }
__device__ __forceinline__ unsigned xb_xcc_id() { return (unsigned)__builtin_amdgcn_s_getreg((3 << 11) | 20) & 0xFu; }
#define XB_SPIN(cond, bar) do { unsigned _sp = 0; while (cond) { __builtin_amdgcn_s_sleep(1); \
    if ((++_sp & 255u) == 0u) { if (xb_ld(&(bar)[XB_TMO])) break; if (_sp > XB_SPIN_CAP) { atomicAdd(&(bar)[XB_TMO], 1u); break; } } } } while (0)

struct XcdBarrier {
    unsigned* bar; unsigned x;
    volatile LAS unsigned* st;
};

__device__ __forceinline__ XcdBarrier xcd_barrier_post(unsigned* bar, volatile LAS unsigned* st) {
    XcdBarrier b; b.bar = bar; b.x = xb_xcc_id(); b.st = st;
    if (threadIdx.x == 0) (void)xb_add(&bar[XB_XCNT(b.x)], 1u);
    return b;
}
__device__ __forceinline__ void xcd_barrier_complete(unsigned* bar, unsigned x, unsigned& nloc, unsigned& nx) {
    const unsigned G = gridDim.x * gridDim.y * gridDim.z;
    unsigned sum, cnt, mine, sp = 0u;
    for (;;) {
        sum = 0u; cnt = 0u; mine = 0u;
#pragma unroll
        for (unsigned j = 0; j < 16; ++j) { const unsigned c = xb_ld(&bar[XB_XCNT(j)]); sum += c; cnt += (c > 0u) ? 1u : 0u; mine = (j == x) ? c : mine; }
        if (sum == G) break;
        __builtin_amdgcn_s_sleep(1);
        if ((++sp & 255u) == 0u) { if (xb_ld(&bar[XB_TMO])) break; if (sp > XB_SPIN_CAP) { atomicAdd(&bar[XB_TMO], 1u); break; } }
    }
    nloc = mine > 0u ? mine : 1u; nx = cnt > 0u ? cnt : 1u;
}

__device__ __forceinline__ void xcd_barrier(const XcdBarrier& b) {
    asm volatile("s_waitcnt vmcnt(0)" ::: "memory");
    __syncthreads();
    if (threadIdx.x == 0) {
        unsigned* bar = b.bar;
        __builtin_amdgcn_s_waitcnt(0);
        unsigned nloc = b.st[0], nx = b.st[1];
        if (nloc == 0u) { xcd_barrier_complete(bar, b.x, nloc, nx); b.st[0] = nloc; b.st[1] = nx; }
        const unsigned old = xb_add(&bar[XB_XSUB(b.x)], 1u);
        const unsigned gen = old / nloc;
        if (old + 1u == (gen + 1u) * nloc) {
            __builtin_amdgcn_fence(__ATOMIC_RELEASE, "agent");
            asm volatile("s_waitcnt vmcnt(0)" ::: "memory");
            const unsigned og = xb_add(&bar[XB_TOP], 1u);
            const unsigned tg = og / nx;
            if (og + 1u == (tg + 1u) * nx) xb_add(&bar[XB_TOPGEN], 1u);
            else XB_SPIN(xb_ld(&bar[XB_TOPGEN]) == tg, bar);
            __builtin_amdgcn_fence(__ATOMIC_ACQUIRE, "agent");
            xb_add(&bar[XB_XGEN(b.x)], 1u);
            asm volatile("s_waitcnt vmcnt(0)" ::: "memory");
        } else {
            XB_SPIN(xb_ld(&bar[XB_XGEN(b.x)]) == gen, bar);
            __builtin_amdgcn_fence(__ATOMIC_ACQUIRE, "agent");
            asm volatile("s_waitcnt vmcnt(0)" ::: "memory");
        }
    }
    __syncthreads();
}

constexpr int NWAVES = 8, NTHREADS = 512, GRID = 256;
constexpr int SEQ = 16384, DM = 1024, FF = 3584, NEXP = 8, NMEM = 256;
constexpr int N_IN0 = 1408, N_IN0P = 1536, N_IN1 = 2560;
constexpr float RMS_EPS = 1e-5f, LOG2E = 1.4426950408889634f, LN2 = 0.6931471805599453f;
constexpr int MOE_MAX_TILES = 136, MOE_MAX_SLOTS = MOE_MAX_TILES * 256;

constexpr size_t MiB = 1u << 20, KiB = 1u << 10;
constexpr size_t WS_CTL = 0, CTL_ZERO_BYTES = 64 * KiB;
constexpr size_t WS_MEMN = 1 * MiB;
constexpr size_t WS_MKV0 = WS_MEMN + 512 * KiB;
constexpr size_t WS_MKV1 = WS_MKV0 + 256 * KiB;
constexpr size_t WS_ROUTE = 2 * MiB;
constexpr size_t WS_GATES = WS_ROUTE + 64 * KiB;
constexpr size_t WS_SDEST = WS_GATES + 128 * KiB;
constexpr size_t WS_SGATE = WS_SDEST + 256 * KiB;
constexpr size_t WS_CNTWG = WS_SGATE + 256 * KiB;
constexpr size_t WS_META = WS_CNTWG + 16 * KiB;
constexpr size_t WS_SLOTOF = WS_META + 16 * KiB;
constexpr size_t WS_LSE = 3 * MiB;
constexpr size_t WS_WIN0 = 4 * MiB;
constexpr size_t WS_WMKV0 = 7 * MiB, WS_WMKV1 = 8 * MiB;
constexpr size_t WS_WOUT0 = 9 * MiB;
constexpr size_t WS_WGU0 = 11 * MiB;
constexpr size_t WS_WD0 = 25 * MiB;
constexpr size_t WS_WIN1 = 32 * MiB;
constexpr size_t WS_WOUT1 = 37 * MiB;
constexpr size_t WS_HN = 38 * MiB;
constexpr size_t WS_WMGU = 70 * MiB;
constexpr size_t WS_WMD = 126 * MiB;
constexpr size_t WS_SS0 = 236 * MiB, WS_SS1 = 237 * MiB;
constexpr size_t WS_HN8 = 154 * MiB;
constexpr size_t WS_XS = 170 * MiB;
constexpr size_t WS_R = 238 * MiB;
constexpr size_t WS_P0 = WS_R, WS_CAT0 = WS_R + 48 * MiB, WS_HID0 = WS_R + 80 * MiB;
constexpr size_t WS_P1 = 154 * MiB, WS_OG = WS_R + 80 * MiB, WS_CAT1 = WS_R + 130 * MiB;
constexpr size_t WS_HIDM = 204 * MiB, WS_PAIR = 324 * MiB, WS_PART = 388 * MiB;
constexpr size_t WS_END = 468 * MiB;
static_assert(WS_HIDM + (size_t)MOE_MAX_SLOTS * FF <= WS_PAIR && WS_PAIR + (size_t)2 * SEQ * DM * 2 <= WS_PART && WS_PART + (size_t)224 * 65536 * 4 <= WS_END && WS_HID0 + (size_t)SEQ * FF * 2 <= WS_END && WS_CAT1 + (size_t)SEQ * 512 * 2 <= WS_END, "ws map");
static_assert(WS_WMD + (size_t)NEXP * DM * FF <= WS_HN8 && WS_XS + (size_t)MOE_MAX_SLOTS * DM <= WS_HIDM && WS_OG + (size_t)3 * SEQ * 256 * 4 <= WS_CAT1, "ws map 2");
constexpr int CW_BAR = 4096;
constexpr int CW_GRP = 8192, CW_XCC = 12288;
static_assert(WS_P1 + (size_t)SEQ * N_IN1 * 2 <= WS_R, "ws map 3");

constexpr int RING_OFF = 0, RING_BYTES = 131072;
constexpr int MISC_OFF = RING_BYTES + 320;
constexpr int LDS_BYTES = 147456;

__device__ __forceinline__ float wave_sum(float v) {
#pragma unroll
    for (int o = 1; o < 64; o <<= 1) v += __shfl_xor(v, o);
    return v;
}
__device__ __forceinline__ int wave_sum_i(int v) {
#pragma unroll
    for (int o = 1; o < 64; o <<= 1) v += __shfl_xor(v, o);
    return v;
}

struct Frame {
    LAS unsigned char* lds;
    volatile LAS unsigned* MISC;
    int tid, lane, wave, bid;
};

__device__ __forceinline__ void p0_transpose_item(const float* W, int K, int N, bf16* WT, int drow0, int k0, int n0, const float* gain, LAS float* scr, int lane) {
#pragma unroll 8
    for (int i = 0; i < 32; ++i) { const int kk = 2 * i + (lane >> 5); scr[kk * 33 + (lane & 31)] = __builtin_nontemporal_load(W + (size_t)(k0 + kk) * N + n0 + (lane & 31)); }
    LDS_WAIT(); asm volatile("" ::: "memory");
    const int c = lane & 7;
    f32x4 ga = {1.f, 1.f, 1.f, 1.f}, gb = ga;
    if (gain) { ga = *(const GAS f32x4*)(gain + k0 + 8 * c); gb = *(const GAS f32x4*)(gain + k0 + 8 * c + 4); }
#pragma unroll
    for (int j = 0; j < 4; ++j) { const int n = (lane >> 3) + 8 * j; const LAS float* s = scr + (8 * c) * 33 + n;
        v4u o; o.x = pk2(s[0 * 33] * ga.x, s[1 * 33] * ga.y); o.y = pk2(s[2 * 33] * ga.z, s[3 * 33] * ga.w); o.z = pk2(s[4 * 33] * gb.x, s[5 * 33] * gb.y); o.w = pk2(s[6 * 33] * gb.z, s[7 * 33] * gb.w);
        *(GAS v4u*)(WT + (size_t)(drow0 + n) * K + k0 + 8 * c) = o; }
    LDS_WAIT(); asm volatile("" ::: "memory");
}
__device__ __forceinline__ void p0_transpose_item_f8(const float* W, int K, int N, unsigned char* WT, int drow0, int k0, int n0, float scale, LAS float* scr, int lane) {
#pragma unroll 8
    for (int i = 0; i < 32; ++i) { const int kk = 2 * i + (lane >> 5); scr[kk * 33 + (lane & 31)] = __builtin_nontemporal_load(W + (size_t)(k0 + kk) * N + n0 + (lane & 31)); }
    LDS_WAIT(); asm volatile("" ::: "memory");
    const int c = lane & 7;
#pragma unroll
    for (int j = 0; j < 4; ++j) { const int n = (lane >> 3) + 8 * j; const LAS float* s = scr + (8 * c) * 33 + n;
        pg8::u32x2 o; o.x = pg8::pk4_fp8(s[0 * 33] * scale, s[1 * 33] * scale, s[2 * 33] * scale, s[3 * 33] * scale); o.y = pg8::pk4_fp8(s[4 * 33] * scale, s[5 * 33] * scale, s[6 * 33] * scale, s[7 * 33] * scale);
        __builtin_nontemporal_store(o, (GAS pg8::u32x2*)(WT + (size_t)(drow0 + n) * K + k0 + 8 * c)); }
    LDS_WAIT(); asm volatile("" ::: "memory");
}
__device__ __forceinline__ void xf8_load(const float* W, int N, int k0, int n0, int lane, f32x4 (&v)[8]) {
#pragma unroll
    for (int i = 0; i < 8; ++i) v[i] = __builtin_nontemporal_load((const GAS f32x4*)(W + (size_t)(k0 + 8 * i + (lane >> 3)) * N + n0 + 4 * (lane & 7)));
}
__device__ __forceinline__ void xf8_proc(const f32x4 (&v)[8], int K, unsigned char* WT, int drow0, int k0, float scale, LAS float* scr, int lane) {
#pragma unroll
    for (int i = 0; i < 8; ++i) { LAS float* d_ = scr + (8 * i + (lane >> 3)) * 33 + 4 * (lane & 7); d_[0] = v[i].x; d_[1] = v[i].y; d_[2] = v[i].z; d_[3] = v[i].w; }
    LDS_WAIT(); asm volatile("" ::: "memory");
    const int c = lane & 7;
#pragma unroll
    for (int j = 0; j < 4; ++j) { const int n = (lane >> 3) + 8 * j; const LAS float* s = scr + (8 * c) * 33 + n;
        pg8::u32x2 o; o.x = pg8::pk4_fp8(s[0 * 33] * scale, s[1 * 33] * scale, s[2 * 33] * scale, s[3 * 33] * scale); o.y = pg8::pk4_fp8(s[4 * 33] * scale, s[5 * 33] * scale, s[6 * 33] * scale, s[7 * 33] * scale);
        __builtin_nontemporal_store(o, (GAS pg8::u32x2*)(WT + (size_t)(drow0 + n) * K + k0 + 8 * c)); }
    LDS_WAIT(); asm volatile("" ::: "memory");
}
struct MoeItem { const float* W; unsigned char* WT; int K, N, drow0, k0, n0; float scale; };
template <bool NT = false>
__device__ __forceinline__ void rms_row(const float* xrow, const float* gain, bf16* obf, int lane) {
    const GAS f32x4* xr = (const GAS f32x4*)xrow + lane; const GAS f32x4* gr = (const GAS f32x4*)gain + lane;
    f32x4 v[4]; float s = 0.f;
#pragma unroll
    for (int j = 0; j < 4; ++j) { v[j] = NT ? __builtin_nontemporal_load(xr + 64 * j) : xr[64 * j]; s += (v[j].x * v[j].x + v[j].y * v[j].y) + (v[j].z * v[j].z + v[j].w * v[j].w); }
    const float rstd = 1.0f / sqrtf(wave_sum(s) * (1.0f / DM) + RMS_EPS);
    GAS unsigned long long* o8 = (GAS unsigned long long*)obf + lane;
#pragma unroll
    for (int j = 0; j < 4; ++j) { const f32x4 g = gr[64 * j]; const f32x4 y = v[j] * rstd * g;
        o8[64 * j] = (unsigned long long)pk2(y.x, y.y) | ((unsigned long long)pk2(y.z, y.w) << 32); }
}
__device__ __forceinline__ void raw_row(const float* xrow, bf16* obf, float* ss, int lane) {
    const GAS f32x4* xr = (const GAS f32x4*)xrow + lane;
    f32x4 v[4]; float s = 0.f;
#pragma unroll
    for (int j = 0; j < 4; ++j) { v[j] = __builtin_nontemporal_load(xr + 64 * j); s += (v[j].x * v[j].x + v[j].y * v[j].y) + (v[j].z * v[j].z + v[j].w * v[j].w); }
    s = wave_sum(s);
    GAS unsigned long long* o8 = (GAS unsigned long long*)obf + lane;
#pragma unroll
    for (int j = 0; j < 4; ++j) o8[64 * j] = (unsigned long long)pk2(v[j].x, v[j].y) | ((unsigned long long)pk2(v[j].z, v[j].w) << 32);
    if (lane == 0) *(GAS f32x4*)ss = (f32x4){s, 0.f, 0.f, 0.f};
}
__device__ __forceinline__ float bf2f(unsigned short b) { return __uint_as_float((unsigned)b << 16); }

constexpr int MOE_ITEMS = 24 * 1792;
constexpr int ATT_ITEMS = 2 * 4 * GRID * NWAVES;
__device__ __forceinline__ void moe_item(const float* wg, const float* wu, const float* wd, unsigned char* wsb, int it, MoeItem& I) {
    const int m = it / 1792, r = it - m * 1792, e = m / 3, kind = m - 3 * e;
    if (kind < 2) { const int kb = r / 112, nb = r - kb * 112, n0 = 32 * nb;
        I.W = (kind == 0 ? wg : wu) + (size_t)e * DM * FF; I.WT = wsb + WS_WMGU + (size_t)e * 2 * FF * DM; I.K = DM; I.N = FF; I.drow0 = 256 * (n0 >> 7) + (n0 & 127) + (kind == 1 ? 128 : 0); I.k0 = 64 * kb; I.n0 = n0; I.scale = 16.f; }
    else { const int kb = r >> 5, nb = r & 31, n0 = 32 * nb;
        I.W = wd + (size_t)e * FF * DM; I.WT = wsb + WS_WMD + (size_t)e * DM * FF; I.K = FF; I.N = DM; I.drow0 = n0; I.k0 = 64 * kb; I.n0 = n0; I.scale = 32.f; }
}
__device__ __forceinline__ void moe_convert_items(const float* wg, const float* wu, const float* wd, unsigned char* wsb, int lo, int hi, int worker, int nworkers, LAS float* scr, int lane) {
    for (int it = lo + worker; it < hi; it += nworkers) { const int m = it / 1792, r = it - m * 1792, e = m / 3, kind = m - 3 * e;
        if (kind < 2) { const int kb = r / 112, nb = r - kb * 112, n0 = 32 * nb;
            p0_transpose_item_f8((kind == 0 ? wg : wu) + (size_t)e * DM * FF, DM, FF, wsb + WS_WMGU + (size_t)e * 2 * FF * DM, 256 * (n0 >> 7) + (n0 & 127) + (kind == 1 ? 128 : 0), 64 * kb, n0, 16.f, scr, lane); }
        else { const int kb = r >> 5, nb = r & 31, n0 = 32 * nb;
            p0_transpose_item_f8(wd + (size_t)e * FF * DM, FF, DM, wsb + WS_WMD + (size_t)e * DM * FF, n0, 64 * kb, n0, 32.f, scr, lane); } }
}
__device__ __forceinline__ void moe_fill_items(const float* wg, const float* wu, const float* wd, unsigned char* wsb, int lo, int hi, int worker, int nworkers, LAS float* scr, int lane) {
    MoeItem I0, I1; f32x4 v0[8], v1[8];
    int it = lo + worker;
    if (it < hi) { moe_item(wg, wu, wd, wsb, it, I0); xf8_load(I0.W, I0.N, I0.k0, I0.n0, lane, v0); }
    for (; it < hi; it += 2 * nworkers) {
        const int it1 = it + nworkers, it2 = it1 + nworkers;
        if (it1 < hi) { moe_item(wg, wu, wd, wsb, it1, I1); xf8_load(I1.W, I1.N, I1.k0, I1.n0, lane, v1); }
        xf8_proc(v0, I0.K, I0.WT, I0.drow0, I0.k0, I0.scale, scr, lane);
        if (it2 < hi) { moe_item(wg, wu, wd, wsb, it2, I0); xf8_load(I0.W, I0.N, I0.k0, I0.n0, lane, v0); }
        if (it1 < hi) xf8_proc(v1, I1.K, I1.WT, I1.drow0, I1.k0, I1.scale, scr, lane);
    }
}
#ifndef FILL1
#define FILL1 12288
#endif
#ifndef FILL2
#define FILL2 12288
#endif
namespace att {
typedef short s16x4 __attribute__((ext_vector_type(4)));
typedef short v4i16_t __attribute__((ext_vector_type(4)));
typedef float f32x16 __attribute__((ext_vector_type(16)));
typedef float f32x2_t __attribute__((ext_vector_type(2)));
typedef __bf16 bf16x2_t __attribute__((ext_vector_type(2)));
constexpr int KSTR = 144, KROWS = 384, K_OFF = 0, V_OFF = KROWS * KSTR, VPLANE = KROWS * 64, B_OFF = V_OFF + 2 * VPLANE, BT_FLOATS = 192, WS_OFF = B_OFF + 12 * BT_FLOATS * 4, OST_OFF = WS_OFF + 1024, ATT_LDS = OST_OFF + NWAVES * 2048;
static_assert(ATT_LDS <= RING_BYTES, "attention LDS");
constexpr float SCALE2 = 0.125f * LOG2E;
constexpr float THR = 8.0f;
__device__ __forceinline__ int crow(int r, int hi) { return (r & 3) + 8 * (r >> 2) + 4 * hi; }
__device__ __forceinline__ unsigned cvtpk(float lo, float hi) { f32x2_t v = {lo, hi}; bf16x2_t b = __builtin_convertvector(v, bf16x2_t); return __builtin_bit_cast(unsigned, b); }
__device__ __forceinline__ s16x4 vtr(const LAS unsigned char* p) { return __builtin_bit_cast(s16x4, __builtin_amdgcn_ds_read_tr16_b64_v4i16((LAS v4i16_t*)p)); }
__device__ __forceinline__ float xhalf_max(float m) { auto rr = __builtin_amdgcn_permlane32_swap(__float_as_uint(m), __float_as_uint(m), false, false); return fmaxf(__uint_as_float(rr[0]), __uint_as_float(rr[1])); }
__device__ __forceinline__ float xhalf_sum(float m) { auto rr = __builtin_amdgcn_permlane32_swap(__float_as_uint(m), __float_as_uint(m), false, false); return __uint_as_float(rr[0]) + __uint_as_float(rr[1]); }
__device__ __forceinline__ int t5_bucket(int d) {
    if (d < 16) return d;
    const int large = 16 + (int)(logf((float)d / 16.0f) / logf(128.0f) * 16.0f);
    return large < 31 ? large : 31;
}
__device__ __forceinline__ void fill_bias_tables(LAS unsigned char* lds, int tid, const float* table, bool dilated) {
    for (int idx = tid; idx < 12 * BT_FLOATS; idx += NTHREADS) { const int h = idx / BT_FLOATS, j = idx - h * BT_FLOATS, o = 159 - j;
        const int dil = dilated ? (1 << (2 * (h >> 2))) : 1, maxd = dilated ? 128 : 127; float val = -1e30f;
        if (o >= 0 && o <= maxd) val = table[t5_bucket(o * dil) * 12 + h] * LOG2E;
        ((LAS float*)(lds + B_OFF))[idx] = val; }
}
struct UnitP { const bf16* qg; const bf16* kg; const bf16* vg; int qpitch, kvpitch, mq0, dil, res, nrows, m0; };
struct StageRegs { v4u k[6], v[6]; bf16x8 q[4]; };
__device__ __forceinline__ void issue_loads(const UnitP& P, StageRegs& R, int tid) {
    const int lane = tid & 63, wave = tid >> 6, r32 = lane & 31, hi = lane >> 5;
#pragma unroll
    for (int it = 0; it < 6; ++it) { const int idx = tid + it * NTHREADS, row = idx >> 3, c = idx & 7;
        if (row < P.nrows) { int m = P.m0 + row; m = m < 0 ? 0 : m; const long tok = (long)m * P.dil + P.res;
            R.k[it] = *(const GAS v4u*)(P.kg + tok * P.kvpitch + c * 8); R.v[it] = *(const GAS v4u*)(P.vg + tok * P.kvpitch + c * 8); } }
    const long qtok = (long)(P.mq0 + 32 * wave + r32) * P.dil + P.res;
#pragma unroll
    for (int s = 0; s < 4; ++s) R.q[s] = *(const GAS bf16x8*)(P.qg + qtok * P.qpitch + hi * 8 + 16 * s);
}
__device__ __forceinline__ void store_lds(LAS unsigned char* lds, const StageRegs& R, int nrows, int tid) {
#pragma unroll
    for (int it = 0; it < 6; ++it) { const int idx = tid + it * NTHREADS, row = idx >> 3, c = idx & 7;
        if (row < nrows) { *(LAS v4u*)(lds + K_OFF + row * KSTR + c * 16) = R.k[it]; *(LAS v4u*)(lds + V_OFF + (c >> 2) * VPLANE + row * 64 + (c & 3) * 16) = R.v[it]; } }
}
template <bool BAND, int OUTMODE>
__device__ __forceinline__ void compute(LAS unsigned char* lds, const bf16x8 (&qr)[4], int tid, int mq0, int dil, int res, int kt_min, int bias_tab, float sink2,
                                        bf16* ob, int opitch, float* lsep) {
    const int lane = tid & 63, wave = __builtin_amdgcn_readfirstlane(tid >> 6), r32 = lane & 31, hi = lane >> 5;
    constexpr int NT = BAND ? 5 : 8;
    const int kt0 = BAND ? wave : 0;
    int t0 = BAND ? kt_min - kt0 : 0; t0 = t0 < 0 ? 0 : t0;
    const LAS unsigned char* kb = lds + K_OFF + (32 * kt0 + r32) * KSTR + hi * 16;
    const LAS float* bl = (const LAS float*)(lds + B_OFF) + bias_tab * BT_FLOATS + (31 - r32 + 4 * hi);
    const int i16 = lane & 15, q4 = i16 >> 2, p4 = i16 & 3, blk16 = (lane >> 4) & 1;
    const LAS unsigned char* vb = lds + V_OFF + (32 * kt0 + 4 * hi + q4) * 64 + blk16 * 32 + p4 * 8;
    LAS float* wsf = (LAS float*)(lds + WS_OFF) + wave * 32;
    float mref = -1e20f, l = 0.f;
    f32x16 o0, o1;
#pragma unroll
    for (int i = 0; i < 16; ++i) { o0[i] = 0.f; o1[i] = 0.f; }
#pragma unroll 1
    for (int t = t0; t < NT; ++t) {
        f32x16 S;
        if (BAND) {
#pragma unroll
            for (int i = 0; i < 16; ++i) S[i] = bl[32 * t + (i & 3) + 8 * (i >> 2)];
        } else {
#pragma unroll
            for (int i = 0; i < 16; ++i) S[i] = 0.f;
        }
#pragma unroll
        for (int s = 0; s < 4; ++s) { const bf16x8 kf = *(const LAS bf16x8*)(kb + t * 32 * KSTR + s * 32); S = __builtin_amdgcn_mfma_f32_32x32x16_bf16(kf, qr[s], S, 0, 0, 0); }
        float m0 = fmaxf(fmaxf(S[0], S[1]), fmaxf(S[2], S[3])), m1 = fmaxf(fmaxf(S[4], S[5]), fmaxf(S[6], S[7])), m2 = fmaxf(fmaxf(S[8], S[9]), fmaxf(S[10], S[11])), m3 = fmaxf(fmaxf(S[12], S[13]), fmaxf(S[14], S[15]));
        const float mt = xhalf_max(fmaxf(fmaxf(m0, m1), fmaxf(m2, m3)));
        if (__any(mt > mref + THR)) {
            const float mnew = fmaxf(mref, mt), f = __builtin_amdgcn_exp2f(mref - mnew);
            mref = mnew; l *= f;
            if (hi == 0) wsf[r32] = f;
            asm volatile("s_waitcnt lgkmcnt(0)" ::: "memory");
#pragma unroll
            for (int i = 0; i < 16; ++i) { const float fi = wsf[crow(i, hi)]; o0[i] *= fi; o1[i] *= fi; }
        }
#pragma unroll
        for (int i = 0; i < 16; ++i) { const float p = __builtin_amdgcn_exp2f(S[i] - mref); S[i] = p; l += p; }
#pragma unroll
        for (int s = 0; s < 2; ++s) {
            v4u pw; pw.x = cvtpk(S[8 * s + 0], S[8 * s + 1]); pw.y = cvtpk(S[8 * s + 2], S[8 * s + 3]); pw.z = cvtpk(S[8 * s + 4], S[8 * s + 5]); pw.w = cvtpk(S[8 * s + 6], S[8 * s + 7]);
            const bf16x8 pa = __builtin_bit_cast(bf16x8, pw);
            const LAS unsigned char* vp = vb + (32 * t + 16 * s) * 64;
            const s16x4 a0 = vtr(vp), a1 = vtr(vp + 8 * 64), b0 = vtr(vp + VPLANE), b1 = vtr(vp + VPLANE + 8 * 64);
            const bf16x8 v0 = __builtin_shufflevector(a0, a1, 0, 1, 2, 3, 4, 5, 6, 7), v1 = __builtin_shufflevector(b0, b1, 0, 1, 2, 3, 4, 5, 6, 7);
            o0 = __builtin_amdgcn_mfma_f32_32x32x16_bf16(pa, v0, o0, 0, 0, 0);
            o1 = __builtin_amdgcn_mfma_f32_32x32x16_bf16(pa, v1, o1, 0, 0, 0);
        }
    }
    l = xhalf_sum(l); l += __builtin_amdgcn_exp2f(sink2 - mref);
    if (hi == 0) wsf[r32] = l;
    asm volatile("s_waitcnt lgkmcnt(0)" ::: "memory");
    float rl[16];
#pragma unroll
    for (int i = 0; i < 16; ++i) rl[i] = 1.0f / wsf[crow(i, hi)];
    LAS unsigned char* ost = lds + OST_OFF + wave * 2048;
#pragma unroll
    for (int half = 0; half < 2; ++half) {
#pragma unroll
        for (int i = 0; i < 16; ++i) *(LAS bf16*)(ost + crow(i, hi) * 64 + r32 * 2) = (bf16)f2bf((half ? o1[i] : o0[i]) * rl[i]);
        asm volatile("s_waitcnt lgkmcnt(0)" ::: "memory");
#pragma unroll
        for (int j = 0; j < 2; ++j) { const int idx = lane + 64 * j, row = idx >> 2, ch = idx & 3;
            const v4u val = *(const LAS v4u*)(ost + row * 64 + ch * 16);
            const long tok = (long)(mq0 + 32 * wave + row) * dil + res;
            *(GAS v4u*)(ob + tok * opitch + 32 * half + ch * 8) = val; }
        asm volatile("s_waitcnt lgkmcnt(0)" ::: "memory");
    }
    if (OUTMODE == 2) { if (hi == 0) lsep[((long)(mq0 + 32 * wave + r32) * dil + res) * 4] = mref * LN2 + logf(l); }
}
}

#ifndef GB_FULL
#define GB_FULL 0
#endif
__device__ __forceinline__ void group_barrier(unsigned* ctl, int grp, unsigned target, volatile LAS unsigned* lightw) {
    asm volatile("s_waitcnt vmcnt(0)" ::: "memory");
    __syncthreads();
    if (threadIdx.x == 0) {
        unsigned* w = ctl + CW_GRP + 64 * grp; unsigned* bar = ctl + CW_BAR;
        __builtin_amdgcn_s_waitcnt(0);
        if (GB_FULL || lightw[0] == 0u) { __builtin_amdgcn_fence(__ATOMIC_RELEASE, "agent"); asm volatile("s_waitcnt vmcnt(0)" ::: "memory"); }
        (void)xb_add(w, 1u);
        XB_SPIN(xb_ld(w) < target, bar);
        __builtin_amdgcn_fence(__ATOMIC_ACQUIRE, "agent");
        asm volatile("s_waitcnt vmcnt(0)" ::: "memory");
    }
    __syncthreads();
}

constexpr int PH_PRO = 0, PH_IN0 = 1, PH_ATT0 = 2, PH_OUT0 = 3, PH_GU0 = 4, PH_D0 = 5, PH_IN1 = 6, PH_ATT1 = 7, PH_COMB = 8, PH_OUT1 = 9,
              PH_ROUTE = 10, PH_SCAT = 11, PH_MOE = 12  , PH_FINAL = 14, N_PHASES = 15;
#ifndef MOE_NC
#define MOE_NC 3
#endif
#ifndef MK_PER_PHASE
#define MK_PER_PHASE 0
#endif
struct Args { const float* in[21]; float* out; unsigned char* ws; int ph_lo, ph_hi; };

__global__ void __launch_bounds__(NTHREADS, 2) fwd(Args args) {
    extern __shared__ __attribute__((aligned(16))) unsigned char lds[];
    Frame F;
    F.lds = (LAS unsigned char*)lds; F.MISC = (volatile LAS unsigned*)(F.lds + MISC_OFF);
    F.tid = threadIdx.x; F.lane = F.tid & 63; F.wave = __builtin_amdgcn_readfirstlane(F.tid >> 6); F.bid = blockIdx.x;
#define ws (args.ws)
    for (int u = F.tid; u < (LDS_BYTES - RING_BYTES) / 4; u += NTHREADS) ((LAS unsigned*)(F.lds + RING_BYTES))[u] = 0u;
    __syncthreads();
    XcdBarrier bar; bar.bar = (unsigned*)(ws + WS_CTL) + CW_BAR; bar.x = 0; bar.st = nullptr;
    if (!MK_PER_PHASE) bar = xcd_barrier_post((unsigned*)(ws + WS_CTL) + CW_BAR, F.MISC + 8);
    if (F.tid == 0) __hip_atomic_store((unsigned*)(ws + WS_CTL) + CW_XCC + F.bid, xb_xcc_id() + 1u, RLX_AGENT);
    const int lo = args.ph_lo, hi = args.ph_hi;
#ifndef ONLY_PHASE
#define ONLY_PHASE -1
#endif
#define IN(k) ((ONLY_PHASE < 0 || ONLY_PHASE == (k) || (ONLY_PHASE == 12 && (k) >= 12 && (k) < 14)) && lo <= (k) && (k) < hi)
#define SEAM(k) do { if (IN(k) && IN((k) + 1)) xcd_barrier(bar); } while (0)
    unsigned gseq = 0;
#define GSEAM(k) do { if (IN(k) && IN((k) + 1)) { ++gseq; group_barrier((unsigned*)(ws + WS_CTL), F.bid & 63, 4u * gseq, F.MISC + 10); } } while (0)
    const int gw = F.bid * NWAVES + F.wave, NGW = GRID * NWAVES;
    const int panel = 8 * (F.bid & 7) + ((F.bid >> 3) & 7), tok64 = 256 * panel + 64 * (F.bid >> 6);
#define x_ (args.in[0])
#define table_ (args.in[2])
#define norm_mix_ (args.in[4])
#define norm_ffn_ (args.in[5])
#define MEMN ((bf16*)(ws + WS_MEMN))
#define MKV0 ((bf16*)(ws + WS_MKV0))
#define MKV1 ((bf16*)(ws + WS_MKV1))
#define HN ((bf16*)(ws + WS_HN))
#define P0 ((bf16*)(ws + WS_P0))
#define CAT0 ((bf16*)(ws + WS_CAT0))
#define HID0 ((bf16*)(ws + WS_HID0))
#define P1 ((bf16*)(ws + WS_P1))
#define OG ((bf16*)(ws + WS_OG))
#define LSE ((float*)(ws + WS_LSE))
#define CAT1 ((bf16*)(ws + WS_CAT1))
#define XS (ws + WS_XS)
#define HIDM (ws + WS_HIDM)
#define HN8 (ws + WS_HN8)
#define PAIR ((bf16*)(ws + WS_PAIR))
#define ROUTE ((unsigned*)(ws + WS_ROUTE))
#define GATES ((float*)(ws + WS_GATES))
#define SDEST ((int*)(ws + WS_SDEST))
#define SGATE ((float*)(ws + WS_SGATE))
#define CNTWG ((int*)(ws + WS_CNTWG))
#define META ((int*)(ws + WS_META))
#define SLOTOF ((int*)(ws + WS_SLOTOF))
#define PART ((float*)(ws + WS_PART))
#define H (args.out)
#define SS0 ((float*)(ws + WS_SS0))
#define SS1 ((float*)(ws + WS_SS1))
    if (IN(PH_PRO)) {
        LAS float* scr = (LAS float*)(F.lds + RING_OFF + F.wave * 16384);
        int off = 0;
        for (int id = 0; id < 9; ++id) {
            const float* src; const float* gain = nullptr; bf16* dst = nullptr; int K, N, mode = 0;
            {
                switch (id) {
                    case 0: src = args.in[7]; dst = (bf16*)(ws + WS_WIN0); K = DM; N = N_IN0; gain = norm_mix_; break;
                    case 1: src = args.in[9]; dst = (bf16*)(ws + WS_WMKV0); K = DM; N = 512; break;
                    case 2: src = args.in[10]; dst = (bf16*)(ws + WS_WOUT0); K = DM; N = DM; break;
                    case 3: src = args.in[14]; dst = (bf16*)(ws + WS_WGU0); K = DM; N = FF; mode = 1; gain = norm_ffn_; break;
                    case 4: src = args.in[15]; dst = (bf16*)(ws + WS_WGU0); K = DM; N = FF; mode = 2; gain = norm_ffn_; break;
                    case 5: src = args.in[16]; dst = (bf16*)(ws + WS_WD0); K = FF; N = DM; break;
                    case 6: src = args.in[11]; dst = (bf16*)(ws + WS_WIN1); K = DM; N = N_IN1; gain = norm_mix_ + DM; break;
                    case 7: src = args.in[12]; dst = (bf16*)(ws + WS_WMKV1); K = DM; N = 512; break;
                    default: src = args.in[13]; dst = (bf16*)(ws + WS_WOUT1); K = 512; N = DM; break;
                }
            }
            const int nnb = N / 32, nit = (K / 64) * nnb;
            int first = gw - off; if (first < 0) first += NGW;
            for (int it = first; it < nit; it += NGW) { const int kb = it / nnb, nb = it % nnb, n0 = 32 * nb;
                const int drow0 = mode == 0 ? n0 : 256 * (n0 >> 7) + (n0 & 127) + (mode == 2 ? 128 : 0);
                p0_transpose_item(src, K, N, dst, drow0, 64 * kb, n0, gain, scr, F.lane); }
            off = (off + nit) % NGW;
        }
        moe_convert_items(args.in[18], args.in[19], args.in[20], ws, FILL1 + FILL2 + ATT_ITEMS, MOE_ITEMS, (gw + NGW - off) % NGW, NGW, scr, F.lane);
        { bf16* wz = (bf16*)(ws + WS_WIN0) + (size_t)N_IN0 * DM;
          for (int i = F.bid * NTHREADS + F.tid; i < (N_IN0P - N_IN0) * DM / 8; i += GRID * NTHREADS) ((GAS v4u*)wz)[i] = (v4u){0u, 0u, 0u, 0u}; }
        for (int m = gw; m < NMEM; m += NGW) rms_row(args.in[1] + (size_t)m * DM, args.in[3], MEMN + (size_t)m * DM, F.lane);
        for (int m = gw; m < SEQ; m += NGW) raw_row(x_ + (size_t)m * DM, HN + (size_t)m * DM, SS1 + (size_t)m * 4, F.lane);
    }
    SEAM(PH_PRO);
    if (IN(PH_PRO) && IN(PH_PRO + 1) && F.tid == 0) {
        unsigned* xc = (unsigned*)(ws + WS_CTL) + CW_XCC + (F.bid & 63); const unsigned a0 = xb_ld(xc), a1 = xb_ld(xc + 64), a2 = xb_ld(xc + 128), a3 = xb_ld(xc + 192);
        F.MISC[10] = (a0 != 0u && a0 == a1 && a0 == a2 && a0 == a3) ? 1u : 0u; }

    if (IN(PH_IN0)) {
        { pg8::Gemm g{HN, (const bf16*)(ws + WS_WIN0), SEQ, N_IN0P, DM, 0}; pg8::StaticOrder S; S.init(SEQ, N_IN0P, GRID, F.bid);
          LAS float* rtab = (LAS float*)(F.lds + MISC_OFF + 5120);
          { pg8::Unit uu; if (S.next(0, uu) && F.tid < 256) rtab[F.tid] = pg8::row_rstd(SS1, uu.pm * 256 + F.tid); }
          __syncthreads();
          pg8::EpiPlainBf16 E{P0, N_IN0P, 0x63Fu, att::SCALE2, rtab};
          pg8::gemm_phase<pg8::EpiPlainBf16, pg8::StaticOrder, true, true>(F.lds + RING_OFF, g, S, E); }
        { pg8::Gemm g{MEMN, (const bf16*)(ws + WS_WMKV0), NMEM, 512, DM, 0}; pg8::StaticOrder S; S.init(NMEM, 512, GRID, (F.bid + 128) & 255);
          pg8::EpiPlainBf16 E{MKV0, 512, 0u, 1.0f, nullptr};
          pg8::gemm_phase<pg8::EpiPlainBf16, pg8::StaticOrder, true, true>(F.lds + RING_OFF, g, S, E); }
        { pg8::Gemm g{MEMN, (const bf16*)(ws + WS_WMKV1), NMEM, 512, DM, 0}; pg8::StaticOrder S; S.init(NMEM, 512, GRID, (F.bid + 126) & 255);
          pg8::EpiPlainBf16 E{MKV1, 512, 0u, 1.0f, nullptr};
          pg8::gemm_phase<pg8::EpiPlainBf16, pg8::StaticOrder, true, true>(F.lds + RING_OFF, g, S, E); }
        if (F.bid >= 132) moe_fill_items(args.in[18], args.in[19], args.in[20], ws, 0, FILL1, (F.bid - 132) * NWAVES + F.wave, 124 * NWAVES, (LAS float*)(F.lds + RING_OFF + F.wave * 16384), F.lane);
    }
    SEAM(PH_IN0);

    if (IN(PH_ATT0)) {
        LAS unsigned char* al = F.lds + RING_OFF;
        att::fill_bias_tables(al, F.tid, table_, false);
        att::StageRegs R; att::UnitP Pn;
#define SWA_UNIT(i) (panel * 12 + 3 * (F.bid >> 6) + (i))
#define MK_UNIT(i, P) do { const int u_ = (i) < 3 ? SWA_UNIT(i) : panel * 4 + (F.bid >> 6) + 768; if ((i) < 3) { const int blk_ = u_ / 12, head_ = u_ % 12, kvh_ = head_ >> 2; \
            P.qg = P0 + 64 * head_; P.kg = P0 + 768 + 64 * kvh_; P.vg = P0 + 960 + 64 * kvh_; P.qpitch = N_IN0P; P.kvpitch = N_IN0P; P.mq0 = 256 * blk_; P.dil = 1; P.res = 0; P.nrows = 384; P.m0 = 256 * blk_ - 128; } \
          else { const int v_ = u_ - 768, blk_ = v_ >> 2, mh_ = v_ & 3; \
            P.qg = P0 + 1152 + 64 * mh_; P.kg = MKV0 + 64 * mh_; P.vg = MKV0 + 256 + 64 * mh_; P.qpitch = N_IN0P; P.kvpitch = 512; P.mq0 = 256 * blk_; P.dil = 1; P.res = 0; P.nrows = 256; P.m0 = 0; } } while (0)
        MK_UNIT(0, Pn); att::issue_loads(Pn, R, F.tid);
#pragma unroll
        for (int i = 0; i < 4; ++i) {
            const att::UnitP Pc = Pn;
            att::store_lds(al, R, Pc.nrows, F.tid);
            const bf16x8 qr[4] = {R.q[0], R.q[1], R.q[2], R.q[3]};
            asm volatile("s_waitcnt lgkmcnt(0)\n\ts_barrier" ::: "memory");
            if (i < 3) { MK_UNIT(i + 1, Pn); att::issue_loads(Pn, R, F.tid); }
            MoeItem CI; f32x4 cv[8];
            moe_item(args.in[18], args.in[19], args.in[20], ws, FILL1 + FILL2 + ((0 * 4 + i) * GRID + F.bid) * NWAVES + F.wave, CI); xf8_load(CI.W, CI.N, CI.k0, CI.n0, F.lane, cv);
            const int u = i < 3 ? SWA_UNIT(i) : panel * 4 + (F.bid >> 6) + 768;
            if (i < 3) { const int blk = u / 12, head = u % 12;
                att::compute<true, 0>(al, qr, F.tid, Pc.mq0, 1, 0, blk == 0 ? 4 : 0, head, args.in[8][head] * LOG2E, CAT0 + 64 * head, DM, nullptr); }
            else { const int mh = (u - 768) & 3;
                att::compute<false, 0>(al, qr, F.tid, Pc.mq0, 1, 0, 0, 0, -1e30f, CAT0 + 768 + 64 * mh, DM, nullptr); }
            asm volatile("s_waitcnt lgkmcnt(0)\n\ts_barrier" ::: "memory");
            xf8_proc(cv, CI.K, CI.WT, CI.drow0, CI.k0, CI.scale, (LAS float*)(al + F.wave * 8448), F.lane);
            asm volatile("s_waitcnt lgkmcnt(0)\n\ts_barrier" ::: "memory");
        }
#undef MK_UNIT
    }
    GSEAM(PH_ATT0);

    if (IN(PH_OUT0)) {
        pg8::Gemm g{CAT0, (const bf16*)(ws + WS_WOUT0), SEQ, DM, DM, 0}; pg8::StaticOrder S; S.init(SEQ, DM, GRID, F.bid);
        pg8::EpiResF32 E{nullptr, HN, nullptr, DM, HN, SS0, MISC_OFF + 1024};
        pg8::gemm_phase<pg8::EpiResF32, pg8::StaticOrder, true, true>(F.lds + RING_OFF, g, S, E);
    }
    GSEAM(PH_OUT0);

    if (IN(PH_GU0)) {
        pg8::Gemm g{HN, (const bf16*)(ws + WS_WGU0), SEQ, 2 * FF, DM, 0}; pg8::StaticOrder S; S.init(SEQ, 2 * FF, GRID, F.bid);
        LAS float* rtab = (LAS float*)(F.lds + MISC_OFF + 5120);
        { pg8::Unit uu; if (S.next(0, uu) && F.tid < 256) rtab[F.tid] = pg8::row_rstd(SS0, uu.pm * 256 + F.tid); }
        __syncthreads();
        pg8::EpiSwiglu E{HID0, FF, 1 << 20, rtab};
        pg8::gemm_phase<pg8::EpiSwiglu, pg8::StaticOrder, true, true>(F.lds + RING_OFF, g, S, E);
    }
    GSEAM(PH_GU0);

    if (IN(PH_D0)) {
        pg8::Gemm g{HID0, (const bf16*)(ws + WS_WD0), SEQ, DM, FF, 0}; pg8::StaticOrder S; S.init(SEQ, DM, GRID, F.bid);
        pg8::EpiResF32 E{nullptr, HN, nullptr, DM, HN, SS1, MISC_OFF + 1024};
        pg8::gemm_phase<pg8::EpiResF32, pg8::StaticOrder, true, true>(F.lds + RING_OFF, g, S, E);
    }
    GSEAM(PH_D0);

    if (IN(PH_IN1)) {
        pg8::Gemm g{HN, (const bf16*)(ws + WS_WIN1), SEQ, N_IN1, DM, 0}; pg8::StaticOrder S; S.init(SEQ, N_IN1, GRID, F.bid);
        LAS float* rtab = (LAS float*)(F.lds + MISC_OFF + 5120);
        { pg8::Unit uu; if (S.next(0, uu) && F.tid < 256) rtab[F.tid] = pg8::row_rstd(SS1, uu.pm * 256 + F.tid); }
        __syncthreads();
        pg8::EpiPlainBf16 E{P1, N_IN1, 0xC30C3u, att::SCALE2, rtab};
        pg8::gemm_phase<pg8::EpiPlainBf16, pg8::StaticOrder, true, true>(F.lds + RING_OFF, g, S, E);
        if (F.bid >= 128) moe_fill_items(args.in[18], args.in[19], args.in[20], ws, FILL1, FILL1 + FILL2, (F.bid - 128) * NWAVES + F.wave, 128 * NWAVES, (LAS float*)(F.lds + RING_OFF + F.wave * 16384), F.lane);
    }
    SEAM(PH_IN1);

    if (IN(PH_ATT1)) {
        LAS unsigned char* al = F.lds + RING_OFF;
        att::fill_bias_tables(al, F.tid, table_, true);
        att::StageRegs R; att::UnitP Pn;
#define MK_UNIT(i, P) do { if ((i) < 3) { const int g_ = (i), h_ = F.bid & 3, sb_ = F.bid >> 2, sh_ = 2 * g_, dil_ = 1 << sh_, res_ = sb_ & (dil_ - 1), blk_ = sb_ >> sh_; \
            P.qg = P1 + 768 * g_ + 64 * h_; P.kg = P1 + 768 * g_ + 256 + 64 * h_; P.vg = P1 + 768 * g_ + 512 + 64 * h_; P.qpitch = N_IN1; P.kvpitch = N_IN1; P.mq0 = 256 * blk_; P.dil = dil_; P.res = res_; P.nrows = 384; P.m0 = 256 * blk_ - 128; } \
          else { const int blk_ = F.bid >> 2, mh_ = F.bid & 3; \
            P.qg = P1 + 2304 + 64 * mh_; P.kg = MKV1 + 64 * mh_; P.vg = MKV1 + 256 + 64 * mh_; P.qpitch = N_IN1; P.kvpitch = 512; P.mq0 = 256 * blk_; P.dil = 1; P.res = 0; P.nrows = 256; P.m0 = 0; } } while (0)
        MK_UNIT(0, Pn); att::issue_loads(Pn, R, F.tid);
#pragma unroll
        for (int i = 0; i < 4; ++i) {
            const att::UnitP Pc = Pn;
            att::store_lds(al, R, Pc.nrows, F.tid);
            const bf16x8 qr[4] = {R.q[0], R.q[1], R.q[2], R.q[3]};
            asm volatile("s_waitcnt lgkmcnt(0)\n\ts_barrier" ::: "memory");
            if (i < 3) { MK_UNIT(i + 1, Pn); att::issue_loads(Pn, R, F.tid); }
            MoeItem CI; f32x4 cv[8];
            moe_item(args.in[18], args.in[19], args.in[20], ws, FILL1 + FILL2 + ((1 * 4 + i) * GRID + F.bid) * NWAVES + F.wave, CI); xf8_load(CI.W, CI.N, CI.k0, CI.n0, F.lane, cv);
            if (i < 3) { const int g = i, h = F.bid & 3;
                att::compute<true, 2>(al, qr, F.tid, Pc.mq0, Pc.dil, Pc.res, Pc.mq0 == 0 ? 4 : 0, 4 * g + h, -1e30f, OG + (size_t)g * SEQ * 256 + 64 * h, 256, LSE + (size_t)g * SEQ * 4 + h); }
            else { const int mh = F.bid & 3;
                att::compute<false, 0>(al, qr, F.tid, Pc.mq0, 1, 0, 0, 0, -1e30f, CAT1 + 256 + 64 * mh, 512, nullptr); }
            asm volatile("s_waitcnt lgkmcnt(0)\n\ts_barrier" ::: "memory");
            xf8_proc(cv, CI.K, CI.WT, CI.drow0, CI.k0, CI.scale, (LAS float*)(al + F.wave * 8448), F.lane);
            asm volatile("s_waitcnt lgkmcnt(0)\n\ts_barrier" ::: "memory");
        }
#undef MK_UNIT
    }
    SEAM(PH_ATT1);

    if (IN(PH_COMB)) {
        for (int t = tok64 + F.wave * 8; t < tok64 + F.wave * 8 + 8; ++t) { const int h = F.lane >> 4;
            const float l0 = LSE[(size_t)t * 4 + h], l1 = LSE[(size_t)(SEQ + t) * 4 + h], l2 = LSE[(size_t)(2 * SEQ + t) * 4 + h];
            const float M = fmaxf(l0, fmaxf(l1, l2)); const float w0 = __expf(l0 - M), w1 = __expf(l1 - M), w2 = __expf(l2 - M); const float inv = 1.0f / (w0 + w1 + w2);
            const unsigned long long ua = ((const GAS unsigned long long*)(OG + (size_t)t * 256))[F.lane], ub = ((const GAS unsigned long long*)(OG + (size_t)(SEQ + t) * 256))[F.lane], uc = ((const GAS unsigned long long*)(OG + (size_t)(2 * SEQ + t) * 256))[F.lane];
            const f32x4 a = {bf2f((unsigned short)ua), bf2f((unsigned short)(ua >> 16)), bf2f((unsigned short)(ua >> 32)), bf2f((unsigned short)(ua >> 48))};
            const f32x4 b = {bf2f((unsigned short)ub), bf2f((unsigned short)(ub >> 16)), bf2f((unsigned short)(ub >> 32)), bf2f((unsigned short)(ub >> 48))};
            const f32x4 c = {bf2f((unsigned short)uc), bf2f((unsigned short)(uc >> 16)), bf2f((unsigned short)(uc >> 32)), bf2f((unsigned short)(uc >> 48))};
            const f32x4 o = (a * w0 + b * w1 + c * w2) * inv;
            ((GAS unsigned long long*)(CAT1 + (size_t)t * 512))[F.lane] = (unsigned long long)pk2(o.x, o.y) | ((unsigned long long)pk2(o.z, o.w) << 32); }
    }
    GSEAM(PH_COMB);

    if (IN(PH_OUT1)) {
        pg8::Gemm g{CAT1, (const bf16*)(ws + WS_WOUT1), SEQ, DM, 512, 0}; pg8::StaticOrder S; S.init(SEQ, DM, GRID, F.bid);
        pg8::EpiResF32 E{nullptr, HN, nullptr, DM, HN, nullptr, 0};
        pg8::gemm_phase<pg8::EpiResF32, pg8::StaticOrder, true, true>(F.lds + RING_OFF, g, S, E);
    }
    GSEAM(PH_OUT1);

    v4u rowreg[8];
    if (IN(PH_ROUTE)) {
        LAS float* grt = (LAS float*)(F.lds + RING_OFF);
        LAS float* red = (LAS float*)(F.lds + RING_OFF + 32768) + F.wave * 2432;
        LAS int* rec = (LAS int*)(F.lds + RING_OFF + 32768 + NWAVES * 9728);
        { const float* gain = norm_ffn_ + DM;
          for (int idx = F.tid; idx < 8192; idx += NTHREADS) { const int k = idx >> 3; grt[(idx & 7) * 1024 + ((k >> 2) & 3) * 256 + (k >> 4) * 4 + (k & 3)] = args.in[17][idx] * gain[k]; } }
        if (F.tid < MOE_MAX_SLOTS / GRID) SDEST[F.bid * (MOE_MAX_SLOTS / GRID) + F.tid] = -1;
        __syncthreads();
        f32x4 gq[4];
#pragma unroll
        for (int q = 0; q < 4; ++q) gq[q] = ((const GAS f32x4*)(norm_ffn_ + DM))[4 * F.lane + q];
#pragma unroll 1
        for (int b = 0; b < 2; ++b) { const int tl0 = F.wave * 8 + 4 * b, t0 = tok64 + tl0;
            f32x4 v[4][4];
#pragma unroll
            for (int i = 0; i < 4; ++i) { const GAS v4u* hr = (const GAS v4u*)(HN + (size_t)(t0 + i) * DM) + 2 * F.lane; const v4u w0 = hr[0], w1 = hr[1];
                v[i][0] = (f32x4){__uint_as_float(w0.x << 16), __uint_as_float(w0.x & 0xffff0000u), __uint_as_float(w0.y << 16), __uint_as_float(w0.y & 0xffff0000u)};
                v[i][1] = (f32x4){__uint_as_float(w0.z << 16), __uint_as_float(w0.z & 0xffff0000u), __uint_as_float(w0.w << 16), __uint_as_float(w0.w & 0xffff0000u)};
                v[i][2] = (f32x4){__uint_as_float(w1.x << 16), __uint_as_float(w1.x & 0xffff0000u), __uint_as_float(w1.y << 16), __uint_as_float(w1.y & 0xffff0000u)};
                v[i][3] = (f32x4){__uint_as_float(w1.z << 16), __uint_as_float(w1.z & 0xffff0000u), __uint_as_float(w1.w << 16), __uint_as_float(w1.w & 0xffff0000u)}; }
#pragma unroll
            for (int i = 0; i < 4; ++i) { float s = 0.f;
#pragma unroll
                for (int q = 0; q < 4; ++q) s += (v[i][q].x * v[i][q].x + v[i][q].y * v[i][q].y) + (v[i][q].z * v[i][q].z + v[i][q].w * v[i][q].w);
                red[F.lane * 37 + 9 * i] = s; }
#pragma unroll 2
            for (int e = 0; e < 8; ++e) { f32x4 r[4];
#pragma unroll
                for (int q = 0; q < 4; ++q) r[q] = *(const LAS f32x4*)(grt + e * 1024 + 256 * q + 4 * F.lane);
#pragma unroll
                for (int i = 0; i < 4; ++i) { float a = 0.f;
#pragma unroll
                    for (int q = 0; q < 4; ++q) a += (v[i][q].x * r[q].x + v[i][q].y * r[q].y) + (v[i][q].z * r[q].z + v[i][q].w * r[q].w);
                    red[F.lane * 37 + 9 * i + 1 + e] = a; } }
            asm volatile("s_waitcnt lgkmcnt(0)" ::: "memory");
            if (F.lane < 36) { float s = 0.f;
#pragma unroll 8
                for (int l = 0; l < 64; ++l) s += red[l * 37 + F.lane];
                red[2368 + F.lane] = s; }
            asm volatile("s_waitcnt lgkmcnt(0)" ::: "memory");
#pragma unroll
            for (int i = 0; i < 4; ++i) { const float rstd = 1.0f / sqrtf(red[2368 + 9 * i] * (1.0f / DM) + RMS_EPS);
                const f32x4 y0 = v[i][0] * rstd * gq[0], y1 = v[i][1] * rstd * gq[1], y2 = v[i][2] * rstd * gq[2], y3 = v[i][3] * rstd * gq[3];
                const v4u pk = {pg8::pk4_fp8(y0.x, y0.y, y0.z, y0.w), pg8::pk4_fp8(y1.x, y1.y, y1.z, y1.w), pg8::pk4_fp8(y2.x, y2.y, y2.z, y2.w), pg8::pk4_fp8(y3.x, y3.y, y3.z, y3.w)};
                if (b == 0) rowreg[i] = pk; else rowreg[4 + i] = pk; }
            if (F.lane < 4) { const int i = F.lane; const float rstd = 1.0f / sqrtf(red[2368 + 9 * i] * (1.0f / DM) + RMS_EPS);
                float lg[8];
#pragma unroll
                for (int e = 0; e < 8; ++e) lg[e] = red[2368 + 9 * i + 1 + e] * rstd;
                int i0 = 0; float v0 = lg[0];
#pragma unroll
                for (int e = 1; e < 8; ++e) if (lg[e] > v0) { v0 = lg[e]; i0 = e; }
                int i1 = -1; float v1 = -3.0e38f;
#pragma unroll
                for (int e = 0; e < 8; ++e) if (e != i0 && lg[e] > v1) { v1 = lg[e]; i1 = e; }
                const float ex = __expf(v1 - v0), g0 = 1.0f / (1.0f + ex), g1 = ex * g0;
                rec[(tl0 + i) * 2] = i0; rec[(tl0 + i) * 2 + 1] = i1; GATES[2 * (t0 + i)] = g0; GATES[2 * (t0 + i) + 1] = g1; }
            asm volatile("s_waitcnt lgkmcnt(0)" ::: "memory");
        }
        __syncthreads();
        if (F.tid < 64) { const int tl = F.tid, e0 = rec[2 * tl], e1 = rec[2 * tl + 1]; int r0 = 0, r1 = 0;
            for (int k = 0; k < tl; ++k) { const int a = rec[2 * k], c = rec[2 * k + 1]; r0 += (a == e0) + (c == e0); r1 += (a == e1) + (c == e1); }
            ROUTE[tok64 + tl] = (unsigned)e0 | ((unsigned)e1 << 8) | ((unsigned)r0 << 16) | ((unsigned)r1 << 24);
        } else if (F.tid < 72) { const int e = F.tid - 64; int s = 0; for (int k = 0; k < 64; ++k) s += (rec[2 * k] == e) + (rec[2 * k + 1] == e); CNTWG[F.bid * 8 + e] = s; }
        __syncthreads();
    }
    SEAM(PH_ROUTE);

    if (IN(PH_SCAT)) {
        LAS int* tab = (LAS int*)(F.lds + RING_OFF);
        LAS int* tot = tab + 2048;
        for (int idx = F.tid; idx < 2048; idx += NTHREADS) tab[idx] = CNTWG[idx];
        const int tb = tok64 + F.wave * 8;
        unsigned rr[8]; v4u row[8]; float gts[16];
#pragma unroll
        for (int j = 0; j < 8; ++j) { rr[j] = ROUTE[tb + j]; row[j] = rowreg[j]; gts[2 * j] = GATES[2 * (tb + j)]; gts[2 * j + 1] = GATES[2 * (tb + j) + 1]; }
        __syncthreads();
        { const int e = F.wave; int s = 0, b = 0;
#pragma unroll
          for (int q = 0; q < 4; ++q) { const int wg = F.lane + 64 * q, c = tab[wg * 8 + e]; s += c; b += (wg < F.bid) ? c : 0; }
          s = wave_sum_i(s); b = wave_sum_i(b); if (F.lane == 0) { tot[e] = s; tot[8 + e] = b; } }
        __syncthreads();
        if (F.bid == 0 && F.tid == 0) { int tp = 0; META[0] = 0; for (int e = 0; e < 8; ++e) { tp += (tot[e] + 255) >> 8; META[e + 1] = tp; } }
        int ebase[8]; { int acc_ = 0;
#pragma unroll
          for (int q = 0; q < 8; ++q) { ebase[q] = acc_ + tot[8 + q]; acc_ += (tot[q] + 255) & ~255; } }
#pragma unroll
        for (int j = 0; j < 8; ++j) {
#pragma unroll
            for (int k = 0; k < 2; ++k) { const int e = (rr[j] >> (8 * k)) & 0xff, lr = (rr[j] >> (16 + 8 * k)) & 0xff; int eb = 0;
#pragma unroll
                for (int q = 0; q < 8; ++q) eb = (q == e) ? ebase[q] : eb;
                const int slot = eb + lr;
                ((GAS v4u*)(XS + (size_t)slot * DM))[F.lane] = row[j];
                if (F.lane == 0) { SDEST[slot] = 2 * (tb + j) + k; SGATE[slot] = gts[2 * j + k]; SLOTOF[2 * (tb + j) + k] = slot; } } }
        __syncthreads();
    }
    SEAM(PH_SCAT);

    if (lo <= PH_MOE + 1 && hi > PH_MOE) {
        if (F.tid < 9) ((LAS int*)(F.lds + MISC_OFF))[16 + F.tid] = META[F.tid];
        __syncthreads();
    }
    if (IN(PH_MOE)) {
        const LAS int* tp = (const LAS int*)(F.lds + MISC_OFF) + 16;
        pg8::Gemm g{(const bf16*)XS, (const bf16*)(ws + WS_WMGU), 0, 0, DM / 2, 0}; pg8::MoeOrder<28> S; S.init(tp[8], F.bid, tp);
        pg8::EpiSwigluF8 E{HIDM, FF, 1.0f / 16.0f};
        pg8::gemm_phase<pg8::EpiSwigluF8, pg8::MoeOrder<28>, true, true, true>(F.lds + RING_OFF, g, S, E);
    }
    SEAM(PH_MOE);
    if (IN(PH_MOE + 1)) {
        const LAS int* tp = (const LAS int*)(F.lds + MISC_OFF) + 16;
        { pg8::Gemm g{(const bf16*)HIDM, (const bf16*)(ws + WS_WMD), 0, 0, FF / 2, 0}; pg8::MoeOrder<4> S; S.init(tp[8] < 128 ? tp[8] : 128, F.bid, tp);
          LAS int* dtab = (LAS int*)(F.lds + MISC_OFF + 5120); LAS float* gtab = (LAS float*)(dtab + 512);
          { pg8::Unit uu;
#pragma unroll
            for (int i = 0; i < 2; ++i) if (S.next(i, uu) && F.tid < 256) { dtab[i * 256 + F.tid] = SDEST[uu.pm * 256 + F.tid]; gtab[i * 256 + F.tid] = SGATE[uu.pm * 256 + F.tid] * (1.0f / 32.0f); } }
          __syncthreads();
          pg8::EpiMoeDown E{PAIR, dtab, gtab, 0};
          pg8::gemm_phase<pg8::EpiMoeDown, pg8::MoeOrder<4>, true, true, true>(F.lds + RING_OFF, g, S, E); }
        { pg8::Gemm g{(const bf16*)HIDM, (const bf16*)(ws + WS_WMD), 0, 0, FF / 2, 4}; pg8::SplitKOrder S; S.init(tp[8], F.bid, tp);
          pg8::EpiPartF32 E{PART};
          pg8::gemm_phase<pg8::EpiPartF32, pg8::SplitKOrder, true, true, true>(F.lds + RING_OFF, g, S, E); }
    }
    SEAM(PH_MOE + 1);

    if (IN(PH_FINAL)) {
        for (int t = gw; t < SEQ; t += NGW) {
            GAS f32x4* xr = (GAS f32x4*)(H + (size_t)t * DM) + F.lane; const GAS f32x4* gr = (const GAS f32x4*)args.in[6] + F.lane;
            f32x4 v[4];
            { const GAS unsigned long long* hr = (const GAS unsigned long long*)(HN + (size_t)t * DM) + F.lane;
#pragma unroll
              for (int q = 0; q < 4; ++q) { const unsigned long long a = __builtin_nontemporal_load(hr + 64 * q);
                  v[q] = (f32x4){bf2f((unsigned short)a), bf2f((unsigned short)(a >> 16)), bf2f((unsigned short)(a >> 32)), bf2f((unsigned short)(a >> 48))}; } }
#pragma unroll
            for (int k = 0; k < 2; ++k) { const int slot = SLOTOF[2 * t + k];
                if ((slot >> 8) < 128) { const GAS unsigned long long* pa = (const GAS unsigned long long*)(PAIR + (size_t)(2 * t + k) * DM) + F.lane;
#pragma unroll
                    for (int q = 0; q < 4; ++q) { const unsigned long long a = __builtin_nontemporal_load(pa + 64 * q);
                        v[q].x += bf2f((unsigned short)a); v[q].y += bf2f((unsigned short)(a >> 16)); v[q].z += bf2f((unsigned short)(a >> 32)); v[q].w += bf2f((unsigned short)(a >> 48)); }
                } else { const int lt = (slot >> 8) - 128, rl = slot & 255; const float gt = GATES[2 * t + k] * (1.0f / 32.0f);
#pragma unroll
                    for (int q = 0; q < 4; ++q) { const GAS f32x4* pp = (const GAS f32x4*)(PART + (size_t)((lt * 4 + q) * 7) * 65536 + rl * 256) + F.lane; f32x4 s = pp[0];
#pragma unroll
                        for (int sl = 1; sl < 7; ++sl) s += pp[(size_t)sl * 16384];
                        v[q] += s * gt; } } }
            float s = 0.f;
#pragma unroll
            for (int q = 0; q < 4; ++q) s += (v[q].x * v[q].x + v[q].y * v[q].y) + (v[q].z * v[q].z + v[q].w * v[q].w);
            const float rstd = 1.0f / sqrtf(wave_sum(s) * (1.0f / DM) + RMS_EPS);
#pragma unroll
            for (int q = 0; q < 4; ++q) __builtin_nontemporal_store(v[q] * rstd * gr[64 * q], xr + 64 * q);
        }
    }
#undef IN
#undef SEAM
#undef ws
}

extern "C" void kernel_launch(void* const* d_in, const int* in_sizes, int n_in, void* d_out, int out_size, void* d_ws, size_t ws_size, hipStream_t stream) {
    static int ready = 0;
    if (ready == 0) {
        if (n_in != 21 || in_sizes[0] != SEQ * DM || out_size != SEQ * DM || ws_size < WS_END) { fprintf(stderr, "kernel_launch: unexpected shapes (n_in %d, in0 %d, out %d, ws %zu); nothing launched\n", n_in, n_in > 0 ? in_sizes[0] : -1, out_size, ws_size); ready = -1; return; }
        if (hipFuncSetAttribute((const void*)fwd, hipFuncAttributeMaxDynamicSharedMemorySize, LDS_BYTES) != hipSuccess) { fprintf(stderr, "kernel_launch: hipFuncSetAttribute failed\n"); ready = -1; return; }
        int per_cu = 0;
        if (hipOccupancyMaxActiveBlocksPerMultiprocessor(&per_cu, (const void*)fwd, NTHREADS, LDS_BYTES) != hipSuccess || per_cu < 1) fprintf(stderr, "kernel_launch: occupancy query reports %d workgroups per CU\n", per_cu);
        (void)hipGetLastError();
        ready = 1;
    }
    if (ready < 0) return;
    if (hipMemsetAsync((char*)d_ws + WS_CTL, 0, CTL_ZERO_BYTES, stream) != hipSuccess) { fprintf(stderr, "kernel_launch: memset failed\n"); return; }
    Args a{};
    for (int i = 0; i < 21; ++i) a.in[i] = (const float*)d_in[i];
    a.out = (float*)d_out; a.ws = (unsigned char*)d_ws;
#if MK_PER_PHASE
    for (int p = 0; p < N_PHASES; ++p) { a.ph_lo = p; a.ph_hi = p + 1; hipLaunchKernelGGL(fwd, dim3(GRID), dim3(NTHREADS), LDS_BYTES, stream, a); }
#else
    a.ph_lo = 0; a.ph_hi = N_PHASES;
    hipLaunchKernelGGL(fwd, dim3(GRID), dim3(NTHREADS), LDS_BYTES, stream, a);
#ifdef PROBE_LIST
    { static const int probe_[] = {PROBE_LIST};
      for (unsigned i = 0; i < sizeof(probe_) / sizeof(int); ++i) { a.ph_lo = probe_[i]; a.ph_hi = probe_[i] + 1; hipLaunchKernelGGL(fwd, dim3(GRID), dim3(NTHREADS), LDS_BYTES, stream, a); } }
#endif
#endif
    const hipError_t le = hipPeekAtLastError();
    if (le != hipSuccess) fprintf(stderr, "kernel_launch: launch failed: %s\n", hipGetErrorName(le));
}
```
